# Optimizing an MI355X kernel written in HIP

```python
import jax, jax.numpy as jnp
from jax import lax
import numpy as np

D_MODEL = 2048
BATCH = 2
SEQ = 16384
DEPTH = 2

HEAD_DIM = 64
ROPE_THETA = 10000.0
RMS_EPS = 1e-6
NEG_INF = -1e30

POOL_WINDOWS = (2, 4, 8, 16)
POOL_GROUPS = 4
POOL_WIDTH = D_MODEL // 4
POOL_GC = POOL_WIDTH // POOL_GROUPS

SWA_HQ = 16
SWA_HKV = 2
SWA_REP = SWA_HQ // SWA_HKV
SWA_WINDOW = 128
SWA_BLOCK = 128
SWA_WIDTH = SWA_HQ * HEAD_DIM
SWA_KV_WIDTH = SWA_HKV * HEAD_DIM

MOBA_HEADS = 8
MOBA_BLOCK = 256
MOBA_TOPK = 3
MOBA_Q_CHUNK = 64
MOBA_WIDTH = MOBA_HEADS * HEAD_DIM

N_BRANCHES = 3
W_IN_COLS = POOL_WIDTH + SWA_WIDTH + 2 * SWA_KV_WIDTH + 3 * MOBA_WIDTH + N_BRANCHES * D_MODEL

N_GROUPS = 4
EXPERTS_PER_GROUP = 8
N_EXPERTS = N_GROUPS * EXPERTS_PER_GROUP
MOE_TOPK = 2
EXPERT_FF = D_MODEL // 2
MOE_BLOCK = 256

kernel_name = 'hybrid_pool_swa_moba_hmoe'


def rms_norm(x, gain):
    xf = x.astype(jnp.float32)
    y = xf * lax.rsqrt(jnp.mean(xf * xf, axis=-1, keepdims=True) + RMS_EPS)
    return y.astype(x.dtype) * gain


def rope_tables(seq_len):
    inv_freq = 1.0 / (ROPE_THETA ** (jnp.arange(0, HEAD_DIM, 2, dtype=jnp.float32) / HEAD_DIM))
    ang = jnp.arange(seq_len, dtype=jnp.float32)[:, None] * inv_freq[None, :]
    return jnp.cos(ang), jnp.sin(ang)


def apply_rope(x, cos, sin):
    xf = x.astype(jnp.float32)
    x1, x2 = jnp.split(xf, 2, axis=-1)
    c = cos[None, :, None, :]
    s = sin[None, :, None, :]
    return jnp.concatenate([x1 * c - x2 * s, x2 * c + x1 * s], axis=-1).astype(x.dtype)


def pool_mixer(xa, pool_w, pool_scale):
    B, S, _ = xa.shape
    xf = xa.astype(jnp.float32)
    csum = jnp.concatenate([jnp.zeros((B, 1, POOL_WIDTH), jnp.float32), jnp.cumsum(xf, axis=1)], axis=1)
    pos = jnp.arange(S)
    outs = []
    for g, w in enumerate(POOL_WINDOWS):
        sl = slice(g * POOL_GC, (g + 1) * POOL_GC)
        lo = jnp.maximum(pos + 1 - w, 0)
        c = csum[..., sl]
        win_sum = jnp.take(c, pos + 1, axis=1) - jnp.take(c, lo, axis=1)
        cnt = (pos + 1 - lo).astype(jnp.float32)[None, :, None]
        pooled = (win_sum / cnt - xf[..., sl]).astype(xa.dtype)
        outs.append(jnp.einsum('bsc,ce->bse', pooled, pool_w[g]))
    return jnp.concatenate(outs, axis=-1) * pool_scale


def shift_prev_block(t):
    pad = [(0, 0), (1, 0)] + [(0, 0)] * (t.ndim - 2)
    return jnp.pad(t, pad)[:, :t.shape[1]]


def swa_attention(q, k, v, sinks):
    B, S, _, Dh = q.shape
    nb = S // SWA_BLOCK
    scale = HEAD_DIM ** -0.5
    qb = q.reshape(B, nb, SWA_BLOCK, SWA_HKV, SWA_REP, Dh)
    kb = k.reshape(B, nb, SWA_BLOCK, SWA_HKV, Dh)
    vb = v.reshape(B, nb, SWA_BLOCK, SWA_HKV, Dh)
    kk = jnp.concatenate([shift_prev_block(kb), kb], axis=2)
    vv = jnp.concatenate([shift_prev_block(vb), vb], axis=2)
    s = jnp.einsum('bnqgrd,bnkgd->bngrqk', qb, kk).astype(jnp.float32) * scale
    qi = jnp.arange(SWA_BLOCK)[:, None]
    kj = jnp.arange(2 * SWA_BLOCK)[None, :]
    dist = qi + SWA_BLOCK - kj
    band = (dist >= 0) & (dist < SWA_WINDOW)
    mask = band[None] & ((jnp.arange(nb)[:, None, None] > 0) | (kj[None] >= SWA_BLOCK))
    s = jnp.where(mask[None, :, None, None], s, NEG_INF)
    sink = sinks.astype(jnp.float32).reshape(1, 1, SWA_HKV, SWA_REP, 1, 1)
    m = jnp.maximum(jnp.max(s, axis=-1, keepdims=True), sink)
    e = jnp.exp(s - m)
    p = (e / (jnp.sum(e, axis=-1, keepdims=True) + jnp.exp(sink - m))).astype(v.dtype)
    o = jnp.einsum('bngrqk,bnkgd->bnqgrd', p, vv)
    return o.reshape(B, S, SWA_HQ * Dh)


def moba_attention(q, k, v):
    B, S, H, Dh = q.shape
    nb = -(-S // MOBA_BLOCK)
    sp = nb * MOBA_BLOCK
    pad = ((0, 0), (0, sp - S), (0, 0), (0, 0))
    q, k, v = jnp.pad(q, pad), jnp.pad(k, pad), jnp.pad(v, pad)
    scale = HEAD_DIM ** -0.5
    k_blocks = k.reshape(B, nb, MOBA_BLOCK, H, Dh)
    v_blocks = v.reshape(B, nb, MOBA_BLOCK, H, Dh)
    k_mean = jnp.mean(k_blocks.astype(jnp.float32), axis=2)
    gate = jnp.einsum('bshd,bnhd->bshn', q.astype(jnp.float32), k_mean)
    q_blk = jnp.arange(sp) // MOBA_BLOCK
    past = jnp.arange(nb)[None, :] < q_blk[:, None]
    gate = jnp.where(past[None, :, None, :], gate, -jnp.inf)
    topk = min(MOBA_TOPK, nb)
    _, sel = lax.top_k(gate, topk)
    sel_ok = sel < q_blk[None, :, None, None]
    k_bh = k_blocks.transpose(0, 3, 1, 2, 4)
    v_bh = v_blocks.transpose(0, 3, 1, 2, 4)
    b_idx = jnp.arange(B)[:, None, None, None]
    h_idx = jnp.arange(H)[None, None, :, None]

    def chunk(c):
        start = c * MOBA_Q_CHUNK
        qc = lax.dynamic_slice_in_dim(q, start, MOBA_Q_CHUNK, axis=1)
        sel_c = lax.dynamic_slice_in_dim(sel, start, MOBA_Q_CHUNK, axis=1)
        ok_c = lax.dynamic_slice_in_dim(sel_ok, start, MOBA_Q_CHUNK, axis=1)
        k_sel = k_bh[b_idx, h_idx, sel_c]
        v_sel = v_bh[b_idx, h_idx, sel_c]
        s_sel = jnp.einsum('bqhd,bqhnkd->bqhnk', qc, k_sel).astype(jnp.float32) * scale
        s_sel = jnp.where(ok_c[..., None], s_sel, NEG_INF).reshape(B, MOBA_Q_CHUNK, H, topk * MOBA_BLOCK)
        own = (start // MOBA_BLOCK) * MOBA_BLOCK
        k_own = lax.dynamic_slice_in_dim(k, own, MOBA_BLOCK, axis=1)
        v_own = lax.dynamic_slice_in_dim(v, own, MOBA_BLOCK, axis=1)
        s_own = jnp.einsum('bqhd,bkhd->bqhk', qc, k_own).astype(jnp.float32) * scale
        causal = (own + jnp.arange(MOBA_BLOCK))[None, :] <= (start + jnp.arange(MOBA_Q_CHUNK))[:, None]
        s_own = jnp.where(causal[None, :, None, :], s_own, NEG_INF)
        p = jax.nn.softmax(jnp.concatenate([s_sel, s_own], axis=-1), axis=-1).astype(v.dtype)
        p_sel = p[..., :topk * MOBA_BLOCK].reshape(B, MOBA_Q_CHUNK, H, topk, MOBA_BLOCK)
        p_own = p[..., topk * MOBA_BLOCK:]
        return (jnp.einsum('bqhnk,bqhnkd->bqhd', p_sel, v_sel)
                + jnp.einsum('bqhk,bkhd->bqhd', p_own, v_own))

    out = lax.map(chunk, jnp.arange(sp // MOBA_Q_CHUNK))
    out = jnp.moveaxis(out, 0, 1).reshape(B, sp, H * Dh)
    return out[:, :S]


def hier_moe(h, w_router_group, w_router_expert, w_exp_gate, w_exp_up, w_exp_down):
    B, S, D = h.shape
    T = B * S
    hf = h.reshape(T, D)
    grp_logits = jnp.einsum('td,dg->tg', hf, w_router_group).astype(jnp.float32)
    grp_prob = jax.nn.softmax(grp_logits, axis=-1)
    g_sel = jnp.argmax(grp_logits, axis=-1).astype(jnp.int32)
    p_grp = jnp.take_along_axis(grp_prob, g_sel[:, None], axis=-1)
    exp_logits = jnp.einsum('td,de->te', hf, w_router_expert).astype(jnp.float32).reshape(T, N_GROUPS, EXPERTS_PER_GROUP)
    within = jnp.take_along_axis(exp_logits, g_sel[:, None, None], axis=1)[:, 0]
    top_p, top_e = lax.top_k(jax.nn.softmax(within, axis=-1), MOE_TOPK)
    weights = p_grp * top_p / jnp.sum(top_p, axis=-1, keepdims=True)
    expert_id = (g_sel[:, None] * EXPERTS_PER_GROUP + top_e).astype(jnp.int32)

    n_assign = T * MOE_TOPK
    flat_e = expert_id.reshape(-1)
    flat_t = jnp.repeat(jnp.arange(T, dtype=jnp.int32), MOE_TOPK)
    flat_w = weights.reshape(-1)
    e_sorted, t_sorted, w_sorted = lax.sort((flat_e, flat_t, flat_w), num_keys=1, is_stable=True)
    counts = jnp.bincount(flat_e, length=N_EXPERTS)
    starts = jnp.cumsum(counts) - counts
    padded = ((counts + MOE_BLOCK - 1) // MOE_BLOCK) * MOE_BLOCK
    p_ends = jnp.cumsum(padded)
    p_starts = p_ends - padded
    rank = jnp.arange(n_assign, dtype=jnp.int32) - starts[e_sorted]
    dest = p_starts[e_sorted] + rank
    n_blocks = -(-n_assign // MOE_BLOCK) + N_EXPERTS
    n_slots = n_blocks * MOE_BLOCK
    slot_tok = jnp.full((n_slots,), T, jnp.int32).at[dest].set(t_sorted)
    slot_w = jnp.zeros((n_slots,), jnp.float32).at[dest].set(w_sorted)
    blk_exp = jnp.minimum(jnp.searchsorted(p_ends, jnp.arange(n_blocks) * MOE_BLOCK, side='right'),
                          N_EXPERTS - 1).astype(jnp.int32)
    hf_pad = jnp.concatenate([hf, jnp.zeros((1, D), hf.dtype)], axis=0)

    def run_block(args):
        tok, wt, e = args
        xb = hf_pad[tok]
        act = jax.nn.silu(xb @ w_exp_gate[e]) * (xb @ w_exp_up[e])
        return (act @ w_exp_down[e]) * wt[:, None].astype(hf.dtype)

    ys = lax.map(run_block, (slot_tok.reshape(n_blocks, MOE_BLOCK), slot_w.reshape(n_blocks, MOE_BLOCK), blk_exp))
    out = jnp.zeros((T + 1, D), hf.dtype).at[slot_tok].add(ys.reshape(n_slots, D))[:T]
    return out.reshape(B, S, D)


def setup_inputs(seed: int = 0) -> dict:
    key = jax.random.key(seed)
    ks = jax.random.split(key, 20)
    f32 = jnp.float32

    def nrm(k, shape, scale):
        return jax.random.normal(k, shape, f32) * scale

    return {
        'x': nrm(ks[0], (BATCH, SEQ, D_MODEL), 1.0),
        'norm_mix': 1.0 + nrm(ks[1], (DEPTH, D_MODEL), 0.02),
        'w_in': nrm(ks[2], (DEPTH, D_MODEL, W_IN_COLS), D_MODEL ** -0.5),
        'pool_w': nrm(ks[3], (DEPTH, POOL_GROUPS, POOL_GC, POOL_GC), POOL_GC ** -0.5),
        'pool_scale': 1.0 + nrm(ks[4], (DEPTH, POOL_WIDTH), 0.02),
        'swa_q_norm': 1.0 + nrm(ks[5], (DEPTH, HEAD_DIM), 0.02),
        'swa_k_norm': 1.0 + nrm(ks[6], (DEPTH, HEAD_DIM), 0.02),
        'swa_sinks': nrm(ks[7], (DEPTH, SWA_HQ), 0.5),
        'moba_q_norm': 1.0 + nrm(ks[8], (DEPTH, HEAD_DIM), 0.02),
        'moba_k_norm': 1.0 + nrm(ks[9], (DEPTH, HEAD_DIM), 0.02),
        'w_up_a': nrm(ks[10], (DEPTH, POOL_WIDTH, D_MODEL), POOL_WIDTH ** -0.5),
        'w_up_b': nrm(ks[11], (DEPTH, SWA_WIDTH, D_MODEL), SWA_WIDTH ** -0.5),
        'w_up_c': nrm(ks[12], (DEPTH, MOBA_WIDTH, D_MODEL), MOBA_WIDTH ** -0.5),
        'w_o': nrm(ks[13], (DEPTH, D_MODEL, D_MODEL), D_MODEL ** -0.5),
        'norm_ffn': 1.0 + nrm(ks[14], (DEPTH, D_MODEL), 0.02),
        'w_router_group': nrm(ks[15], (DEPTH, D_MODEL, N_GROUPS), D_MODEL ** -0.5),
        'w_router_expert': nrm(ks[16], (DEPTH, D_MODEL, N_EXPERTS), D_MODEL ** -0.5),
        'w_exp_gate': nrm(ks[17], (DEPTH, N_EXPERTS, D_MODEL, EXPERT_FF), D_MODEL ** -0.5),
        'w_exp_up': nrm(ks[18], (DEPTH, N_EXPERTS, D_MODEL, EXPERT_FF), D_MODEL ** -0.5),
        'w_exp_down': nrm(ks[19], (DEPTH, N_EXPERTS, EXPERT_FF, D_MODEL), EXPERT_FF ** -0.5),
    }


def reference(x, norm_mix, w_in, pool_w, pool_scale, swa_q_norm, swa_k_norm, swa_sinks,
              moba_q_norm, moba_k_norm, w_up_a, w_up_b, w_up_c, w_o, norm_ffn,
              w_router_group, w_router_expert, w_exp_gate, w_exp_up, w_exp_down):
    B, S, _ = x.shape
    cos, sin = rope_tables(S)
    offsets = np.cumsum([POOL_WIDTH, SWA_WIDTH, SWA_KV_WIDTH, SWA_KV_WIDTH,
                         MOBA_WIDTH, MOBA_WIDTH, MOBA_WIDTH]).tolist()
    for l in range(DEPTH):
        h = rms_norm(x, norm_mix[l])
        proj = jnp.einsum('bsd,dc->bsc', h, w_in[l])
        xa, qb, kb, vb, qm, km, vm, gate_logits = jnp.split(proj, offsets, axis=-1)
        y_a = pool_mixer(xa, pool_w[l], pool_scale[l])
        q_b = apply_rope(rms_norm(qb.reshape(B, S, SWA_HQ, HEAD_DIM), swa_q_norm[l]), cos, sin)
        k_b = apply_rope(rms_norm(kb.reshape(B, S, SWA_HKV, HEAD_DIM), swa_k_norm[l]), cos, sin)
        y_b = swa_attention(q_b, k_b, vb.reshape(B, S, SWA_HKV, HEAD_DIM), swa_sinks[l])
        q_c = apply_rope(rms_norm(qm.reshape(B, S, MOBA_HEADS, HEAD_DIM), moba_q_norm[l]), cos, sin)
        k_c = apply_rope(rms_norm(km.reshape(B, S, MOBA_HEADS, HEAD_DIM), moba_k_norm[l]), cos, sin)
        y_c = moba_attention(q_c, k_c, vm.reshape(B, S, MOBA_HEADS, HEAD_DIM))
        gates = jax.nn.sigmoid(gate_logits.astype(jnp.float32)).astype(x.dtype)
        g_a, g_b, g_c = jnp.split(gates, N_BRANCHES, axis=-1)
        merged = (g_a * jnp.einsum('bsc,cd->bsd', y_a, w_up_a[l])
                  + g_b * jnp.einsum('bsc,cd->bsd', y_b, w_up_b[l])
                  + g_c * jnp.einsum('bsc,cd->bsd', y_c, w_up_c[l]))
        x = x + jnp.einsum('bsd,de->bse', merged, w_o[l])
        x = x + hier_moe(rms_norm(x, norm_ffn[l]), w_router_group[l], w_router_expert[l],
                         w_exp_gate[l], w_exp_up[l], w_exp_down[l])
    return x
```

```cpp
#include <hip/hip_runtime.h>
#include <cstdio>
#include <cstdint>

#ifndef MK_N_LAUNCHES
#define MK_N_LAUNCHES 1
#endif

#ifndef FP8_MOE
#define FP8_MOE 1
#endif
#ifndef FP8_IN
#define FP8_IN 1
#endif
#ifndef FP8_O
#define FP8_O 1
#endif
#ifndef PROBE_DUP
#define PROBE_DUP -1
#endif

#define LAS __attribute__((address_space(3)))
#define GAS __attribute__((address_space(1)))
typedef unsigned short bf16_t;
typedef short bf16x8 __attribute__((ext_vector_type(8)));
typedef short s16x4 __attribute__((ext_vector_type(4)));
typedef float f32x2 __attribute__((ext_vector_type(2)));
typedef float f32x4 __attribute__((ext_vector_type(4)));
typedef float f32x16 __attribute__((ext_vector_type(16)));
typedef unsigned u32x2 __attribute__((ext_vector_type(2)));
typedef unsigned u32x4 __attribute__((ext_vector_type(4)));
typedef GAS unsigned gu32;
typedef int v8i32 __attribute__((ext_vector_type(8)));
typedef int v4i32 __attribute__((ext_vector_type(4)));

constexpr int BATCH = 2, SEQ = 16384, T = BATCH * SEQ, D = 2048, DEPTH = 2;
constexpr int PW = 9472;
constexpr int XA_OFF = 0, QB_OFF = 512, KB_OFF = 1536, VB_OFF = 1664, QM_OFF = 1792, KM_OFF = 2304, VM_OFF = 2816, G_OFF = 3328;
constexpr int NEXP = 32, FF = 1024, CAP = 65536;
constexpr int NWAVES = 8, NTHR = 512;
constexpr float RMS_EPS = 1e-6f;
constexpr float LOG2E = 1.4426950408889634f;
constexpr float C2 = 0.125f * LOG2E;

constexpr size_t MiB = 1u << 20;
constexpr size_t WS_CTL = 0, CTL_ZERO_BYTES = 1 * MiB;
constexpr size_t WS_ROPE = 2 * MiB;
constexpr size_t WS_KMP = 6 * MiB;
constexpr size_t WS_SEL = 7 * MiB;
constexpr size_t WS_ML = 8 * MiB;
constexpr size_t WS_TOKR = 16 * MiB;
constexpr size_t WS_RS1 = 16 * MiB + 512 * 1024, WS_RS2 = 16 * MiB + 640 * 1024;
constexpr size_t WS_SLOT_TOK = 17 * MiB;
constexpr size_t WS_SLOT_W = 25 * MiB;
constexpr size_t WS_LOGITS = 33 * MiB;
constexpr size_t WS_WIN = 49 * MiB;
constexpr size_t WS_WIN8 = 62 * MiB;
constexpr size_t WS_WUPA = 85 * MiB;
constexpr size_t WS_WO = 93 * MiB;
constexpr size_t WS_WR = 101 * MiB;
constexpr size_t WS_POOLW = 102 * MiB;
constexpr size_t WS_W13 = 104 * MiB;
constexpr size_t WS_WD = 360 * MiB;
constexpr size_t WS_G8A = 232 * MiB, WS_G8B = 296 * MiB, WS_G8C = 424 * MiB;
static_assert(WS_G8B == WS_G8A + 64 * MiB && WS_G8C == WS_G8A + 192 * MiB, "EpiGate8 branch offsets");
constexpr size_t WS_H = 488 * MiB;
constexpr size_t WS_PROJ = 617 * MiB;
constexpr size_t WS_ACT = 617 * MiB;
constexpr size_t WS_Y = 761 * MiB;
constexpr size_t WS_YA = 1209 * MiB;
constexpr size_t WS_MERGED = 1337 * MiB;
constexpr size_t WS_OPART = 1465 * MiB;
constexpr size_t WS_H8 = 1657 * MiB;
constexpr size_t WS_X = 1721 * MiB;
constexpr size_t WS_END = 1849 * MiB;
static_assert(WS_PROJ + (size_t)T * PW * 2 <= WS_YA && WS_Y + (size_t)73728 * 2048 * 2 <= WS_YA && WS_WIN8 + (size_t)6144 * D <= WS_WUPA, "ws map");

constexpr int CW_TMO = 0;
constexpr int CW_BAR = 4096;
constexpr int CW_CNT = 8192;
constexpr int CW_Q = 8448;

constexpr int RING_BYTES = 131072;
constexpr int MISC_OFF = RING_BYTES;
constexpr int LDS_BYTES = 147456;

__device__ __forceinline__ unsigned f2bf(float f) { unsigned u = __builtin_bit_cast(unsigned, f); return (u + 0x7fffu + ((u >> 16) & 1u)) >> 16; }
__device__ __forceinline__ unsigned pk2(float lo, float hi) { return f2bf(lo) | (f2bf(hi) << 16); }
__device__ __forceinline__ float bflo(unsigned w) { return __builtin_bit_cast(float, w << 16); }
__device__ __forceinline__ float bfhi(unsigned w) { return __builtin_bit_cast(float, w & 0xffff0000u); }
typedef __bf16 bf16x2_t __attribute__((ext_vector_type(2)));
__device__ __forceinline__ unsigned cvt_pk_bf16(float lo, float hi) { const f32x2 v = {lo, hi}; const bf16x2_t b = __builtin_convertvector(v, bf16x2_t); return __builtin_bit_cast(unsigned, b); }
constexpr int F8_WSH = 5, F8_HSH = 3, F8_ASH = 2, F8_YSH = 6, F8_GSH = 4, F8_MSH = 4;
__device__ __forceinline__ float clamp448(float v) { return __builtin_fminf(__builtin_fmaxf(v, -448.f), 448.f); }
__device__ __forceinline__ unsigned pk4_fp8(float a, float b, float c, float d) {
    int p = 0; p = __builtin_amdgcn_cvt_pk_fp8_f32(clamp448(a), clamp448(b), p, false); p = __builtin_amdgcn_cvt_pk_fp8_f32(clamp448(c), clamp448(d), p, true); return (unsigned)p; }
#define LDS_WAIT() asm volatile("s_waitcnt lgkmcnt(0)" ::: "memory")
#define VM_WAIT() asm volatile("s_waitcnt vmcnt(0)" ::: "memory")
#define RLX_AGENT __ATOMIC_RELAXED, __HIP_MEMORY_SCOPE_AGENT

namespace pg8 {
constexpr int BM = 256, BK = 64, HALF = 128, HTB = HALF * BK * 2, STAGE_BYTES = 8 * HTB, NXCD = 8, WGM = 8;
__host__ __device__ __forceinline__ int lds_byte(int r, int c) { const int st = (r >> 4) * 2 + (c >> 5), rr = r & 15, cc = c & 31, ob = rr * 64 + cc * 2; return st * 1024 + (ob ^ (((ob >> 9) & 1) << 5)); }
__host__ __device__ __forceinline__ void stage_rc(int b, int& R, int& C) { const int st = b / 1024, sb = b % 1024, swz = sb ^ (((sb >> 9) & 1) << 5); R = (st >> 1) * 16 + swz / 64; C = (st & 1) * 32 + (swz % 64) / 2; }
__host__ __device__ __forceinline__ int perm32(int rho) { const int n = rho >> 4, i = rho & 15; return 8 * (i >> 2) + 4 * n + (i & 3); }

struct Unit { int pm, pn, e, nrow, rank0; };

__device__ __forceinline__ bool static_tile(int nM, int nN, int G, int c, int i, int& pm, int& pn) {
    const int nwg = nM * nN; const long L = (long)i * G + c; if (L >= nwg) return false;
    int wgid = (int)L; { const int q = nwg / NXCD, r = nwg % NXCD, xcd = wgid % NXCD, off = wgid / NXCD; wgid = (xcd < r ? xcd * (q + 1) : r * (q + 1) + (xcd - r) * q) + off; }
    const int nig = WGM * nN, gid = wgid / nig, fm = gid * WGM, gsz = (nM - fm) < WGM ? (nM - fm) : WGM;
    pm = fm + ((wgid % nig) % gsz); pn = (wgid % nig) / gsz; return true;
}
struct UnevenSched {
    static constexpr bool GATHER = false;
    const void* A; const void* Bt; int nM, nN, Kb, G, c;
    __device__ __forceinline__ bool next(int i, Unit& u) const {
        u.e = 0; u.nrow = 256; u.rank0 = 0;
        if (G != 256) return static_tile(nM, nN, G, c, i, u.pm, u.pn);
        int L;
        if (i < 11) L = i * 256 + c; else if (c >= 128 && i < 13) L = 2816 + 2 * (c - 128) + (i - 11); else return false;
        return static_tile(nM, nN, nM * nN, L, 0, u.pm, u.pn);
    }
    __device__ __forceinline__ const char* a_base(const Unit& u) const { return (const char*)A + (size_t)u.pm * 256 * Kb; }
    __device__ __forceinline__ const char* b_base(const Unit& u) const { return (const char*)Bt + (size_t)u.pn * 256 * Kb; }
    __device__ __forceinline__ unsigned gather(const Unit&, int) const { return 0u; }
};
struct SplitKSched {
    static constexpr bool GATHER = false;
    const void* A; const void* Bt; int nM, Kb, G, c;
    __device__ __forceinline__ bool next(int i, Unit& u) const { const int L = i * G + c; if (L >= 2 * nM) return false; u.pm = L >> 1; u.pn = L & 1; u.e = 0; u.nrow = 256; u.rank0 = 0; return true; }
    __device__ __forceinline__ const char* a_base(const Unit& u) const { return (const char*)A + (size_t)u.pm * 256 * Kb + (size_t)u.pn * (Kb / 2); }
    __device__ __forceinline__ const char* b_base(const Unit& u) const { return (const char*)Bt + (size_t)u.pn * (Kb / 2); }
    __device__ __forceinline__ unsigned gather(const Unit&, int) const { return 0u; }
};
struct DenseSched {
    static constexpr bool GATHER = false;
    const void* A; const void* Bt; int nM, nN, Kb, G, c;
    __device__ __forceinline__ bool next(int i, Unit& u) const { u.e = 0; u.nrow = 256; u.rank0 = 0; return static_tile(nM, nN, G, c, i, u.pm, u.pn); }
    __device__ __forceinline__ const char* a_base(const Unit& u) const { return (const char*)A + (size_t)u.pm * 256 * Kb; }
    __device__ __forceinline__ const char* b_base(const Unit& u) const { return (const char*)Bt + (size_t)u.pn * 256 * Kb; }
    __device__ __forceinline__ unsigned gather(const Unit&, int) const { return 0u; }
};

template <class E, class = void> struct HasMid { static constexpr bool v = false; };
template <class E> struct HasMid<E, decltype((void)E::MID)> { static constexpr bool v = E::MID; };
template <class Epi, class Sched, bool ALIGN_EPI = false, bool SP2 = true, bool FP8 = false, int SC_B = 127, int SC_A = 127>
__device__ __forceinline__ void gemm_phase(LAS unsigned char* lds, const int Kb, const Sched& S, const Epi& E, const int nt_override = 0) {
    int tid_ = threadIdx.x; asm volatile("" : "+v"(tid_));
    const int tid = tid_, wid = __builtin_amdgcn_readfirstlane(tid >> 6), lane = tid & 63, wr = wid >> 2, wc = wid & 3, fr = lane & 15, fq = lane >> 4;
    const int nt = nt_override ? nt_override : Kb / 128;
    constexpr bool GATHER = Sched::GATHER;
    int RA[2], CA[2]; unsigned voffB[2];
#pragma unroll
    for (int i = 0; i < 2; ++i) { int R, C; stage_rc(tid * 16 + i * 8192, R, C); RA[i] = R; CA[i] = C; const int Rb = Epi::PERM ? (64 * (R >> 5) + perm32(R & 31)) : R; voffB[i] = (unsigned)(Rb * Kb + C * 2); }
    const size_t kstep = (size_t)(BK * 2);
    const size_t hstepB = (size_t)(Epi::PERM ? 32 : HALF) * Kb;
    const size_t hstepA = GATHER ? (size_t)0 : (size_t)HALF * Kb;
    const unsigned ldsw = (unsigned)wid * 1024u;
    const int aoff = lds_byte(wr * 64 + fr, fq * 8), boff = lds_byte(wc * 32 + fr, fq * 8);
#define PG8_SA(b, h) (((b) * 2 + (h)) * HTB)
#define PG8_SB(b, h) ((4 + (b) * 2 + (h)) * HTB)
#define PG8_STAGE(bufoff, gbase, voff) do { _Pragma("unroll") for (int _i = 0; _i < 2; ++_i) \
        __builtin_amdgcn_global_load_lds((const unsigned*)((const char*)(gbase) + (voff)[_i]), (LAS unsigned*)(lds + (bufoff) + ldsw + _i * 8192), 16, 0, 0); } while (0)
#define PG8_LD8(base) __builtin_shufflevector(*(const LAS v4i32*)(base), *(const LAS v4i32*)((base) + 1024), 0, 1, 2, 3, 4, 5, 6, 7)
#define PG8_LDA(dst, b, h) do { _Pragma("unroll") for (int m = 0; m < 4; ++m) dst[m] = PG8_LD8(lds + PG8_SA(b, h) + aoff + m * 2048); } while (0)
#define PG8_LDB(dst, b, h) do { _Pragma("unroll") for (int n = 0; n < 2; ++n) dst[n] = PG8_LD8(lds + PG8_SB(b, h) + boff + n * 2048); } while (0)
#define PG8_LO(v) __builtin_bit_cast(bf16x8, __builtin_shufflevector(v, v, 0, 1, 2, 3))
#define PG8_HI(v) __builtin_bit_cast(bf16x8, __builtin_shufflevector(v, v, 4, 5, 6, 7))
#define PG8_MMA(ai, bj, At, Bt) do { __builtin_amdgcn_s_setprio(1); _Pragma("unroll") for (int m = 0; m < 4; ++m) _Pragma("unroll") for (int n = 0; n < 2; ++n) { \
        if constexpr (FP8) asm volatile("v_mfma_scale_f32_16x16x128_f8f6f4 %0, %1, %2, %0, %3, %4 op_sel_hi:[0,0,0]" : "+v"(acc[ai][bj][m][n]) : "v"(Bt[n]), "v"(At[m]), "v"(scb), "v"(sca)); \
        else { acc[ai][bj][m][n] = __builtin_amdgcn_mfma_f32_16x16x32_bf16(PG8_LO(Bt[n]), PG8_LO(At[m]), acc[ai][bj][m][n], 0, 0, 0); \
               acc[ai][bj][m][n] = __builtin_amdgcn_mfma_f32_16x16x32_bf16(PG8_HI(Bt[n]), PG8_HI(At[m]), acc[ai][bj][m][n], 0, 0, 0); } } \
        __builtin_amdgcn_s_setprio(0); } while (0)
#define PG8_WAIT_V(n) asm volatile("s_waitcnt vmcnt(" #n ")" ::: "memory")
#define PG8_WAIT_L(n) asm volatile("s_waitcnt lgkmcnt(" #n ")" ::: "memory")
#define PG8_BAR __builtin_amdgcn_s_barrier()
#define PG8_SCHED __builtin_amdgcn_sched_barrier(0)
    Unit cur, nxt; int ui = 0;
    if (!S.next(0, cur)) return;
    f32x4 acc[2][2][4][2];
#pragma unroll
    for (int a = 0; a < 2; ++a)
#pragma unroll
        for (int b = 0; b < 2; ++b)
#pragma unroll
            for (int m = 0; m < 4; ++m)
#pragma unroll
                for (int n = 0; n < 2; ++n) acc[a][b][m][n] = (f32x4){0.f, 0.f, 0.f, 0.f};
    v8i32 At[4], B0[2], B1[2];
    const int scb = SC_B * 0x01010101, sca = SC_A * 0x01010101;
    unsigned voffA0[2], voffA1[2], nvA0[2], nvA1[2];
#pragma unroll
    for (int i = 0; i < 2; ++i) {
        if constexpr (GATHER) { voffA0[i] = S.gather(cur, RA[i]) + (unsigned)CA[i] * 2u; voffA1[i] = S.gather(cur, RA[i] + HALF) + (unsigned)CA[i] * 2u; nvA0[i] = voffA0[i]; nvA1[i] = voffA1[i]; }
        else { voffA0[i] = (unsigned)(RA[i] * Kb + CA[i] * 2); }
    }
#define VA0 voffA0
#define VA1 (GATHER ? voffA1 : voffA0)
    const char* cA = S.a_base(cur); const char* cB = S.b_base(cur);
    if constexpr (SP2) {
        PG8_STAGE(PG8_SB(0, 0), cB, voffB); PG8_STAGE(PG8_SB(0, 1), cB + hstepB, voffB); PG8_STAGE(PG8_SA(0, 0), cA, voffA0); PG8_STAGE(PG8_SA(0, 1), cA + hstepA, VA1);
        if (wr == 1) PG8_BAR;
        PG8_WAIT_V(2); PG8_BAR;
        PG8_STAGE(PG8_SB(1, 0), cB + kstep, voffB); PG8_STAGE(PG8_SA(1, 0), cA + kstep, voffA0); PG8_STAGE(PG8_SB(1, 1), cB + hstepB + kstep, voffB);
        PG8_WAIT_V(6); PG8_BAR;
    } else {
        PG8_STAGE(PG8_SB(0, 0), cB, voffB); PG8_STAGE(PG8_SA(0, 0), cA, voffA0); PG8_STAGE(PG8_SB(0, 1), cB + hstepB, voffB); PG8_STAGE(PG8_SA(0, 1), cA + hstepA, VA1);
        if (wr == 1) PG8_BAR;
        PG8_WAIT_V(4); PG8_BAR;
        PG8_STAGE(PG8_SB(1, 0), cB + kstep, voffB); PG8_STAGE(PG8_SA(1, 0), cA + kstep, voffA0); PG8_STAGE(PG8_SB(1, 1), cB + hstepB + kstep, voffB);
        PG8_WAIT_V(6); PG8_BAR;
    }
    for (;;) {
        const bool has_next = S.next(ui + 1, nxt);
        const char* nA = has_next ? S.a_base(nxt) : cA; const char* nB = has_next ? S.b_base(nxt) : cB;
        if constexpr (GATHER) {
#pragma unroll
            for (int i = 0; i < 2; ++i) {
                if (has_next) { nvA0[i] = S.gather(nxt, RA[i]) + (unsigned)CA[i] * 2u; nvA1[i] = S.gather(nxt, RA[i] + HALF) + (unsigned)CA[i] * 2u; }
                else { nvA0[i] = voffA0[i]; nvA1[i] = voffA1[i]; }
            }
        }
#pragma unroll 1
        for (int t = 0; t < nt; t += 2) {
            if constexpr (HasMid<Epi>::v) { if (t == Epi::MID_T0 || t == Epi::MID_T1) {
                if constexpr (FP8) {
#pragma unroll
                    for (int a = 0; a < 2; ++a)
#pragma unroll
                        for (int b = 0; b < 2; ++b)
                            asm volatile("s_nop 15\n\ts_nop 15" : "+v"(acc[a][b][0][0]), "+v"(acc[a][b][0][1]), "+v"(acc[a][b][1][0]), "+v"(acc[a][b][1][1]), "+v"(acc[a][b][2][0]), "+v"(acc[a][b][2][1]), "+v"(acc[a][b][3][0]), "+v"(acc[a][b][3][1]));
                }
                E.mid(acc, cur, t == Epi::MID_T1 ? 1 : 0, wr, wc, fr, fq);
                if constexpr (FP8) {
#pragma unroll
                    for (int a = 0; a < 2; ++a)
#pragma unroll
                        for (int b = 0; b < 2; ++b)
                            asm volatile("s_nop 7" : "+v"(acc[a][b][0][0]), "+v"(acc[a][b][0][1]), "+v"(acc[a][b][1][0]), "+v"(acc[a][b][1][1]), "+v"(acc[a][b][2][0]), "+v"(acc[a][b][2][1]), "+v"(acc[a][b][3][0]), "+v"(acc[a][b][3][1]));
                } } }
            const bool last = (t == nt - 2);
            const char* a1 = cA + (size_t)(t + 1) * kstep;
            const char* a2 = last ? nA : cA + (size_t)(t + 2) * kstep; const char* b2 = last ? nB : cB + (size_t)(t + 2) * kstep;
            const char* a3 = a2 + kstep; const char* b3 = b2 + kstep;
            unsigned vA0[2], vA1[2];
#pragma unroll
            for (int i = 0; i < 2; ++i) { if constexpr (GATHER) { vA0[i] = last ? nvA0[i] : voffA0[i]; vA1[i] = last ? nvA1[i] : voffA1[i]; } else { vA0[i] = voffA0[i]; vA1[i] = voffA0[i]; } }
            if constexpr (SP2) {
            PG8_LDB(B0, 0, 0); PG8_LDB(B1, 0, 1); PG8_SCHED; PG8_LDA(At, 0, 0); PG8_STAGE(PG8_SA(1, 1), a1 + hstepA, VA1);
            PG8_WAIT_V(8); PG8_WAIT_L(0); PG8_BAR; PG8_MMA(0, 0, At, B0); PG8_MMA(0, 1, At, B1); PG8_BAR; PG8_SCHED;
            PG8_LDA(At, 0, 1); PG8_STAGE(PG8_SB(0, 0), b2, voffB); PG8_STAGE(PG8_SB(0, 1), b2 + hstepB, voffB); PG8_STAGE(PG8_SA(0, 0), a2, vA0);
            PG8_WAIT_V(8); PG8_WAIT_L(0); PG8_BAR; PG8_MMA(1, 0, At, B0); PG8_MMA(1, 1, At, B1); PG8_BAR; PG8_SCHED;
            PG8_LDB(B0, 1, 0); PG8_LDB(B1, 1, 1); PG8_SCHED; PG8_LDA(At, 1, 0); PG8_STAGE(PG8_SA(0, 1), a2 + hstepA, vA1);
            PG8_WAIT_V(8); PG8_WAIT_L(0); PG8_BAR; PG8_MMA(0, 0, At, B0); PG8_MMA(0, 1, At, B1); PG8_BAR; PG8_SCHED;
            PG8_LDA(At, 1, 1); PG8_STAGE(PG8_SB(1, 0), b3, voffB); PG8_STAGE(PG8_SB(1, 1), b3 + hstepB, voffB); PG8_STAGE(PG8_SA(1, 0), a3, vA0);
            PG8_WAIT_V(8); PG8_WAIT_L(0); PG8_BAR; PG8_MMA(1, 0, At, B0); PG8_MMA(1, 1, At, B1); PG8_BAR; PG8_SCHED;
            } else {
            PG8_LDB(B0, 0, 0); PG8_SCHED; PG8_LDA(At, 0, 0); PG8_STAGE(PG8_SA(1, 1), a1 + hstepA, VA1);
            PG8_WAIT_L(8); PG8_BAR; PG8_WAIT_L(0); PG8_MMA(0, 0, At, B0); PG8_BAR; PG8_SCHED;
            PG8_LDB(B1, 0, 1); PG8_STAGE(PG8_SB(0, 0), b2, voffB);
            PG8_BAR; PG8_WAIT_L(0); PG8_MMA(0, 1, At, B1); PG8_BAR;
            PG8_LDA(At, 0, 1); PG8_STAGE(PG8_SA(0, 0), a2, vA0);
            PG8_BAR; PG8_WAIT_L(0); PG8_MMA(1, 0, At, B0); PG8_BAR; PG8_SCHED;
            PG8_STAGE(PG8_SB(0, 1), b2 + hstepB, voffB);
            PG8_WAIT_V(6); PG8_BAR; PG8_MMA(1, 1, At, B1); PG8_BAR;
            PG8_LDB(B0, 1, 0); PG8_SCHED; PG8_LDA(At, 1, 0); PG8_STAGE(PG8_SA(0, 1), a2 + hstepA, vA1);
            PG8_WAIT_L(8); PG8_BAR; PG8_WAIT_L(0); PG8_MMA(0, 0, At, B0); PG8_BAR; PG8_SCHED;
            PG8_LDB(B1, 1, 1); PG8_STAGE(PG8_SB(1, 0), b3, voffB);
            PG8_BAR; PG8_WAIT_L(0); PG8_MMA(0, 1, At, B1); PG8_BAR;
            PG8_LDA(At, 1, 1); PG8_STAGE(PG8_SA(1, 0), a3, vA0);
            PG8_BAR; PG8_WAIT_L(0); PG8_MMA(1, 0, At, B0); PG8_BAR; PG8_SCHED;
            PG8_STAGE(PG8_SB(1, 1), b3 + hstepB, voffB);
            PG8_WAIT_V(6); PG8_BAR; PG8_MMA(1, 1, At, B1); PG8_BAR;
            }
        }
        if constexpr (ALIGN_EPI) { if (wr == 0) PG8_BAR; }
        if constexpr (FP8) {
#pragma unroll
            for (int a = 0; a < 2; ++a)
#pragma unroll
                for (int b = 0; b < 2; ++b)
                    asm volatile("s_nop 15\n\ts_nop 15" : "+v"(acc[a][b][0][0]), "+v"(acc[a][b][0][1]), "+v"(acc[a][b][1][0]), "+v"(acc[a][b][1][1]), "+v"(acc[a][b][2][0]), "+v"(acc[a][b][2][1]), "+v"(acc[a][b][3][0]), "+v"(acc[a][b][3][1]));
        }
        E(acc, cur, wr, wc, fr, fq);
        if (!has_next) break;
#pragma unroll
        for (int a = 0; a < 2; ++a)
#pragma unroll
            for (int b = 0; b < 2; ++b)
#pragma unroll
                for (int m = 0; m < 4; ++m)
#pragma unroll
                    for (int n = 0; n < 2; ++n) acc[a][b][m][n] = (f32x4){0.f, 0.f, 0.f, 0.f};
        cur = nxt; cA = nA; cB = nB; ++ui;
        if constexpr (GATHER) {
#pragma unroll
            for (int i = 0; i < 2; ++i) { voffA0[i] = nvA0[i]; voffA1[i] = nvA1[i]; } }
        if constexpr (ALIGN_EPI) { if (wr == 1) PG8_BAR; }
    }
    PG8_WAIT_V(0);
    if constexpr (!ALIGN_EPI) { if (wr == 0) PG8_BAR; }
    PG8_BAR;
#undef VA0
#undef VA1
#undef PG8_SA
#undef PG8_SB
#undef PG8_STAGE
#undef PG8_LD8
#undef PG8_LO
#undef PG8_HI
#undef PG8_LDA
#undef PG8_LDB
#undef PG8_MMA
#undef PG8_WAIT_V
#undef PG8_WAIT_L
#undef PG8_BAR
#undef PG8_SCHED
}

__device__ __forceinline__ float sigmoidf_fast(float x) { return __builtin_amdgcn_rcpf(1.0f + __builtin_amdgcn_exp2f(-x * LOG2E)); }

template <bool SIG> struct EpiProj {
    static constexpr bool PERM = true;
    bf16_t* O; int pn0; const float* rs;
    __device__ __forceinline__ void operator()(const f32x4 (&acc)[2][2][4][2], const Unit& u, int wr, int wc, int fr_in, int fq_in) const {
        int fr = fr_in, fq = fq_in; asm volatile("" : "+v"(fr), "+v"(fq));
        const int row0 = u.pm * BM + wr * 64 + fr, col0 = (pn0 + u.pn) * BM + wc * 64 + 8 * fq; constexpr bool sig = SIG;
#pragma unroll
        for (int ai = 0; ai < 2; ++ai)
#pragma unroll
            for (int m = 0; m < 4; ++m) { bf16_t* rowp = O + (size_t)(row0 + ai * HALF + m * 16) * PW + col0; const float rr = rs[row0 + ai * HALF + m * 16];
#pragma unroll
                for (int bj = 0; bj < 2; ++bj) { f32x4 v0 = acc[ai][bj][m][0] * rr, v1 = acc[ai][bj][m][1] * rr;
                    if (sig) {
#pragma unroll
                        for (int j = 0; j < 4; ++j) { v0[j] = sigmoidf_fast(v0[j]); v1[j] = sigmoidf_fast(v1[j]); } }
                    u32x4 w; w.x = cvt_pk_bf16(v0[0], v0[1]); w.y = cvt_pk_bf16(v0[2], v0[3]); w.z = cvt_pk_bf16(v1[0], v1[1]); w.w = cvt_pk_bf16(v1[2], v1[3]);
                    *(u32x4*)(rowp + bj * 32) = w; } }
    }
};
struct EpiGate8 {
    static constexpr bool PERM = true;
    unsigned char* g8;
    __device__ __forceinline__ void operator()(const f32x4 (&acc)[2][2][4][2], const Unit& u, int wr, int wc, int fr_in, int fq_in) const {
        int fr = fr_in, fq = fq_in; asm volatile("" : "+v"(fr), "+v"(fq));
        const int row0 = u.pm * BM + wr * 64 + fr, col0 = (u.pn & 7) * BM + wc * 64 + 8 * fq; const int br = u.pn >> 3; unsigned char* base = g8 + ((size_t)(br + (br >> 1)) << 26);
        constexpr float sc = (float)(1 << F8_GSH);
#pragma unroll
        for (int ai = 0; ai < 2; ++ai)
#pragma unroll
            for (int m = 0; m < 4; ++m) { unsigned char* rowp = base + (size_t)(row0 + ai * HALF + m * 16) * D + col0;
#pragma unroll
                for (int bj = 0; bj < 2; ++bj) { const f32x4 v0 = acc[ai][bj][m][0] * sc, v1 = acc[ai][bj][m][1] * sc;
                    u32x2 w; w.x = pk4_fp8(v0[0], v0[1], v0[2], v0[3]); w.y = pk4_fp8(v1[0], v1[1], v1[2], v1[3]);
                    *(u32x2*)(rowp + bj * 32) = w; } }
    }
};
struct EpiUpH {
    static constexpr bool PERM = true, MID = true; static constexpr int MID_T0 = 4, MID_T1 = 12;
    const unsigned char* G; unsigned char* M8;
    __device__ __forceinline__ void mid(f32x4 (&acc)[2][2][4][2], const Unit& u, int which, int wr, int wc, int fr_in, int fq_in) const {
        int fr = fr_in, fq = fq_in; asm volatile("" : "+v"(fr), "+v"(fq));
        const int row0 = u.pm * BM + wr * 64 + fr, col0 = u.pn * BM + wc * 64 + 8 * fq;
        const unsigned char* G1 = G + (which ? ((size_t)1 << 26) : (size_t)0); const unsigned char* G2 = G + (which ? ((size_t)3 << 26) : ((size_t)1 << 26));
        constexpr float gs = -LOG2E / (float)(1 << F8_GSH);
#pragma unroll
        for (int ai = 0; ai < 2; ++ai) {
            u32x2 g1[4][2], g2[4][2];
#pragma unroll
            for (int m = 0; m < 4; ++m)
#pragma unroll
                for (int bj = 0; bj < 2; ++bj) { const size_t off = (size_t)(row0 + ai * HALF + m * 16) * D + col0 + bj * 32;
                    g1[m][bj] = *(const u32x2*)(G1 + off); g2[m][bj] = *(const u32x2*)(G2 + off); }
            asm volatile("" ::: "memory");
#pragma unroll
            for (int m = 0; m < 4; ++m)
#pragma unroll
                for (int bj = 0; bj < 2; ++bj) { const u32x2 a = g1[m][bj], b = g2[m][bj];
#define RT(w1, w2, k) ((1.0f + __builtin_amdgcn_exp2f(__builtin_amdgcn_cvt_f32_fp8((int)(w2), k) * gs)) * __builtin_amdgcn_rcpf(1.0f + __builtin_amdgcn_exp2f(__builtin_amdgcn_cvt_f32_fp8((int)(w1), k) * gs)))
                    acc[ai][bj][m][0][0] *= RT(a.x, b.x, 0); acc[ai][bj][m][0][1] *= RT(a.x, b.x, 1); acc[ai][bj][m][0][2] *= RT(a.x, b.x, 2); acc[ai][bj][m][0][3] *= RT(a.x, b.x, 3);
                    acc[ai][bj][m][1][0] *= RT(a.y, b.y, 0); acc[ai][bj][m][1][1] *= RT(a.y, b.y, 1); acc[ai][bj][m][1][2] *= RT(a.y, b.y, 2); acc[ai][bj][m][1][3] *= RT(a.y, b.y, 3);
#undef RT
                }
            asm volatile("" ::: "memory");
        }
    }
    __device__ __forceinline__ void operator()(const f32x4 (&acc)[2][2][4][2], const Unit& u, int wr, int wc, int fr_in, int fq_in) const {
        int fr = fr_in, fq = fq_in; asm volatile("" : "+v"(fr), "+v"(fq));
        const int row0 = u.pm * BM + wr * 64 + fr, col0 = u.pn * BM + wc * 64 + 8 * fq;
        const unsigned char* G3 = G + ((size_t)3 << 26);
        constexpr float gs = -LOG2E / (float)(1 << F8_GSH), sc = (float)(1 << F8_HSH);
#pragma unroll
        for (int ai = 0; ai < 2; ++ai) {
            u32x2 g[4][2];
#pragma unroll
            for (int m = 0; m < 4; ++m)
#pragma unroll
                for (int bj = 0; bj < 2; ++bj) g[m][bj] = *(const u32x2*)(G3 + (size_t)(row0 + ai * HALF + m * 16) * D + col0 + bj * 32);
            asm volatile("" ::: "memory");
#pragma unroll
            for (int m = 0; m < 4; ++m)
#pragma unroll
                for (int bj = 0; bj < 2; ++bj) { const u32x2 gg = g[m][bj]; const f32x4 v0 = acc[ai][bj][m][0], v1 = acc[ai][bj][m][1];
#define SG(w, k) (sc * __builtin_amdgcn_rcpf(1.0f + __builtin_amdgcn_exp2f(__builtin_amdgcn_cvt_f32_fp8((int)(w), k) * gs)))
                    u32x2 w; w.x = pk4_fp8(v0[0] * SG(gg.x, 0), v0[1] * SG(gg.x, 1), v0[2] * SG(gg.x, 2), v0[3] * SG(gg.x, 3));
                    w.y = pk4_fp8(v1[0] * SG(gg.y, 0), v1[1] * SG(gg.y, 1), v1[2] * SG(gg.y, 2), v1[3] * SG(gg.y, 3));
#undef SG
                    *(u32x2*)(M8 + (size_t)(row0 + ai * HALF + m * 16) * D + col0 + bj * 32) = w; }
            asm volatile("" ::: "memory");
        }
    }
};
template <bool BASE_F32> struct EpiResid {
    static constexpr bool PERM = true; static constexpr int NSTORE = 16;
    const float* basef; bf16_t* X;
    __device__ __forceinline__ void operator()(const f32x4 (&acc)[2][2][4][2], const Unit& u, int wr, int wc, int fr_in, int fq_in) const {
        int fr = fr_in, fq = fq_in; asm volatile("" : "+v"(fr), "+v"(fq));
        const int row0 = u.pm * BM + wr * 64 + fr, col0 = u.pn * BM + wc * 64 + 8 * fq;
#pragma unroll
        for (int ai = 0; ai < 2; ++ai) {
            f32x4 b0[4][2], b1[4][2];
#pragma unroll
            for (int m = 0; m < 4; ++m)
#pragma unroll
                for (int bj = 0; bj < 2; ++bj) { const size_t off = (size_t)(row0 + ai * HALF + m * 16) * D + col0 + bj * 32;
                    if constexpr (BASE_F32) { b0[m][bj] = *(const f32x4*)(basef + off); b1[m][bj] = *(const f32x4*)(basef + off + 4); }
                    else { const u32x4 r = *(const u32x4*)(X + off); b0[m][bj] = (f32x4){bflo(r.x), bfhi(r.x), bflo(r.y), bfhi(r.y)}; b1[m][bj] = (f32x4){bflo(r.z), bfhi(r.z), bflo(r.w), bfhi(r.w)}; } }
            asm volatile("" ::: "memory");
#pragma unroll
            for (int m = 0; m < 4; ++m)
#pragma unroll
                for (int bj = 0; bj < 2; ++bj) { const size_t off = (size_t)(row0 + ai * HALF + m * 16) * D + col0 + bj * 32;
                    const f32x4 v0 = b0[m][bj] + acc[ai][bj][m][0], v1 = b1[m][bj] + acc[ai][bj][m][1];
                    u32x4 w; w.x = cvt_pk_bf16(v0[0], v0[1]); w.y = cvt_pk_bf16(v0[2], v0[3]); w.z = cvt_pk_bf16(v1[0], v1[1]); w.w = cvt_pk_bf16(v1[2], v1[3]);
                    *(u32x4*)(X + off) = w; }
            asm volatile("" ::: "memory");
        }
    }
};
struct EpiLogits {
    static constexpr bool PERM = false;
    float* L; const float* rs; float scale;
    __device__ __forceinline__ void operator()(const f32x4 (&acc)[2][2][4][2], const Unit& u, int wr, int wc, int fr_in, int fq_in) const {
        int fr = fr_in, fq = fq_in; asm volatile("" : "+v"(fr), "+v"(fq));
        if (wc >= 2) return;
        const int row0 = u.pm * BM + wr * 64 + fr, col0 = wc * 32 + 4 * fq; float* Lk = L + (size_t)u.pn * ((size_t)T * 64);
#pragma unroll
        for (int ai = 0; ai < 2; ++ai)
#pragma unroll
            for (int m = 0; m < 4; ++m) { float* rp = Lk + (size_t)(row0 + ai * HALF + m * 16) * 64 + col0; const float rr = rs[row0 + ai * HALF + m * 16];
#pragma unroll
                for (int n = 0; n < 2; ++n) *(f32x4*)(rp + n * 16) = acc[ai][0][m][n] * rr; }
    }
};
template <bool F8> struct EpiAct {
    static constexpr bool PERM = true;
    unsigned char* A;
    __device__ __forceinline__ void operator()(const f32x4 (&acc)[2][2][4][2], const Unit& u, int wr, int wc, int fr_in, int fq_in) const {
        int fr = fr_in, fq = fq_in; asm volatile("" : "+v"(fr), "+v"(fq));
        const int row0 = u.pm * BM + wr * 64 + fr, col0 = u.pn * HALF + wc * 32 + 8 * fq;
#pragma unroll
        for (int ai = 0; ai < 2; ++ai)
#pragma unroll
            for (int m = 0; m < 4; ++m) { float v[8];
#pragma unroll
                for (int n = 0; n < 2; ++n)
#pragma unroll
                    for (int j = 0; j < 4; ++j) { const float g = acc[ai][0][m][n][j], up = acc[ai][1][m][n][j]; v[4 * n + j] = g * sigmoidf_fast(g) * up; }
                if constexpr (F8) { constexpr float sc = (float)(1 << F8_ASH);
                    u32x2 w; w.x = pk4_fp8(v[0] * sc, v[1] * sc, v[2] * sc, v[3] * sc); w.y = pk4_fp8(v[4] * sc, v[5] * sc, v[6] * sc, v[7] * sc);
                    *(u32x2*)(A + (size_t)(row0 + ai * HALF + m * 16) * FF + col0) = w; }
                else { u32x4 w; w.x = cvt_pk_bf16(v[0], v[1]); w.y = cvt_pk_bf16(v[2], v[3]); w.z = cvt_pk_bf16(v[4], v[5]); w.w = cvt_pk_bf16(v[6], v[7]);
                    *(u32x4*)((bf16_t*)A + (size_t)(row0 + ai * HALF + m * 16) * FF + col0) = w; } }
    }
};
struct EpiDown {
    static constexpr bool PERM = true;
    unsigned char* Y; const float* slot_w;
    __device__ __forceinline__ void operator()(const f32x4 (&acc)[2][2][4][2], const Unit& u, int wr, int wc, int fr_in, int fq_in) const {
        int fr = fr_in, fq = fq_in; asm volatile("" : "+v"(fr), "+v"(fq));
        const int rl0 = wr * 64 + fr, col0 = u.pn * BM + wc * 64 + 8 * fq;
#pragma unroll
        for (int ai = 0; ai < 2; ++ai)
#pragma unroll
            for (int m = 0; m < 4; ++m) { const int rl = rl0 + ai * HALF + m * 16; const float w8 = (rl < u.nrow) ? slot_w[(size_t)u.e * CAP + (size_t)u.rank0 + rl] * (float)(1 << F8_YSH) : 0.f;
                unsigned char* rowp = Y + (size_t)(u.pm * BM + rl) * D + col0;
#pragma unroll
                for (int bj = 0; bj < 2; ++bj) { const f32x4 v0 = acc[ai][bj][m][0] * w8, v1 = acc[ai][bj][m][1] * w8;
                    u32x2 w; w.x = pk4_fp8(v0[0], v0[1], v0[2], v0[3]); w.y = pk4_fp8(v1[0], v1[1], v1[2], v1[3]);
                    *(u32x2*)(rowp + bj * 32) = w; } }
    }
};
}

#define XB_TMO      128
#define XB_XCNT(j)  (256  + 64 * (j))
#define XB_XSUB(j)  (1280 + 64 * (j))
#define XB_XGEN(j)  (2304 + 64 * (j))
#define XB_TOP      3328
#define XB_TOPGEN   3392
#define XCD_BAR_WORDS 3456
#define XB_SPIN_CAP (1u << 18)
__device__ __forceinline__ unsigned xb_ld(unsigned* p)              { return __hip_atomic_load(p, __ATOMIC_RELAXED, __HIP_MEMORY_SCOPE_AGENT); }
__device__ __forceinline__ unsigned xb_add(unsigned* p, unsigned v) { return __hip_atomic_fetch_add(p, v, __ATOMIC_RELAXED, __HIP_MEMORY_SCOPE_AGENT); }
__device__ __forceinline__ unsigned xb_xcc_id() { return (unsigned)__builtin_amdgcn_s_getreg((3 << 11) | 20) & 0xFu; }
#define XB_SPIN(cond, bar) do { unsigned _sp = 0; while (cond) { __builtin_amdgcn_s_sleep(1); \
    if ((++_sp & 255u) == 0u) { if (xb_ld(&(bar)[XB_TMO])) break; if (_sp > XB_SPIN_CAP) { atomicAdd(&(bar)[XB_TMO], 1u); break; } } } } while (0)
struct XcdBarrier { unsigned* bar; unsigned x; volatile LAS unsigned* st; };
__device__ __forceinline__ XcdBarrier xcd_barrier_post(unsigned* bar, volatile LAS unsigned* st) {
    XcdBarrier b; b.bar = bar; b.x = xb_xcc_id(); b.st = st;
    if (threadIdx.x == 0) (void)xb_add(&bar[XB_XCNT(b.x)], 1u);
    return b;
}
__device__ __forceinline__ void xcd_barrier_complete(unsigned* bar, unsigned x, unsigned& nloc, unsigned& nx) {
    const unsigned G = gridDim.x * gridDim.y * gridDim.z;
    unsigned sum, cnt, mine, sp = 0u;
    for (;;) {
        sum = 0u; cnt = 0u; mine = 0u;
#pragma unroll
        for (unsigned j = 0; j < 16; ++j) { const unsigned c = xb_ld(&bar[XB_XCNT(j)]); sum += c; cnt += (c > 0u) ? 1u : 0u; mine = (j == x) ? c : mine; }
        if (sum == G) break;
        __builtin_amdgcn_s_sleep(1);
        if ((++sp & 255u) == 0u) { if (xb_ld(&bar[XB_TMO])) break; if (sp > XB_SPIN_CAP) { atomicAdd(&bar[XB_TMO], 1u); break; } }
    }
    nloc = mine > 0u ? mine : 1u; nx = cnt > 0u ? cnt : 1u;
}
__device__ __forceinline__ void xcd_barrier(const XcdBarrier& b) {
    asm volatile("s_waitcnt vmcnt(0)" ::: "memory");
    __syncthreads();
    if (threadIdx.x == 0) {
        unsigned* bar = b.bar;
        __builtin_amdgcn_s_waitcnt(0);
        unsigned nloc = b.st[0], nx = b.st[1];
        if (nloc == 0u) { xcd_barrier_complete(bar, b.x, nloc, nx); b.st[0] = nloc; b.st[1] = nx; }
        const unsigned old = xb_add(&bar[XB_XSUB(b.x)], 1u);
        const unsigned gen = old / nloc;
        if (old + 1u == (gen + 1u) * nloc) {
            __builtin_amdgcn_fence(__ATOMIC_RELEASE, "agent");
            asm volatile("s_waitcnt vmcnt(0)" ::: "memory");
            const unsigned og = xb_add(&bar[XB_TOP], 1u);
            const unsigned tg = og / nx;
            if (og + 1u == (tg + 1u) * nx) xb_add(&bar[XB_TOPGEN], 1u);
            else XB_SPIN(xb_ld(&bar[XB_TOPGEN]) == tg, bar);
            __builtin_amdgcn_fence(__ATOMIC_ACQUIRE, "agent");
            xb_add(&bar[XB_XGEN(b.x)], 1u);
            asm volatile("s_waitcnt vmcnt(0)" ::: "memory");
        } else {
            XB_SPIN(xb_ld(&bar[XB_XGEN(b.x)]) == gen, bar);
            __builtin_amdgcn_fence(__ATOMIC_ACQUIRE, "agent");
            asm volatile("s_waitcnt vmcnt(0)" ::: "memory");
        }
    }
    __syncthreads();
}

struct Args { const float* in[20]; float* out; unsigned char* ws; float inv_freq[32]; int ph_lo, ph_hi; };
enum { I_X = 0, I_NORM_MIX, I_W_IN, I_POOL_W, I_POOL_SCALE, I_SWA_QN, I_SWA_KN, I_SWA_SINKS, I_MOBA_QN, I_MOBA_KN, I_W_UP_A, I_W_UP_B, I_W_UP_C, I_W_O, I_NORM_FFN,
       I_W_RG, I_W_RE, I_W_EG, I_W_EU, I_W_ED };

typedef const __attribute__((address_space(4))) Args* ArgsP;
struct Frame {
    LAS unsigned char* lds;
    gu32* ctl;
    unsigned char* ws;
    ArgsP ap;
    int tid, lane, wave, G, bid;
};
__device__ __forceinline__ float wave_sum(float v) {
#pragma unroll
    for (int o = 1; o < 64; o <<= 1) v += __shfl_xor(v, o);
    return v;
}

__device__ __forceinline__ void transpose_item(const float* W, int K, int N, bf16_t* WT, int kb, int nb, int rowbase, LAS float* scr, int lane, const float* kgain = nullptr, int dpitch = 0) {
    const int DP = dpitch ? dpitch : K;
    const int k0 = 64 * kb, n0 = 32 * nb;
#pragma unroll 8
    for (int i = 0; i < 32; ++i) { const int kk = 2 * i + (lane >> 5); const float gk = kgain ? kgain[k0 + kk] : 1.0f; scr[kk * 33 + (lane & 31)] = W[(size_t)(k0 + kk) * N + n0 + (lane & 31)] * gk; }
    LDS_WAIT(); asm volatile("" ::: "memory");
    const int c = lane & 7;
#pragma unroll
    for (int j = 0; j < 4; ++j) { const int n = (lane >> 3) + 8 * j; const LAS float* s = scr + (8 * c) * 33 + n;
        u32x4 o; o.x = pk2(s[0 * 33], s[1 * 33]); o.y = pk2(s[2 * 33], s[3 * 33]); o.z = pk2(s[4 * 33], s[5 * 33]); o.w = pk2(s[6 * 33], s[7 * 33]);
        *(GAS u32x4*)(WT + (size_t)(rowbase + n) * DP + k0 + 8 * c) = o; }
    LDS_WAIT(); asm volatile("" ::: "memory");
}
template <bool ILV>
__device__ __forceinline__ void transpose_item_fp8(const float* W, int K, int N, unsigned char* WT, int kb, int nb, int rowbase, LAS unsigned char* scr, int lane, int dpitch = 0) {
    const int DP = dpitch ? dpitch : K;
    const int k0 = 128 * kb, n0 = 64 * nb; constexpr float sc = (float)(1 << F8_WSH);
    const float* wp = W + (size_t)k0 * N + n0 + lane;
    float va[32], vb[32];
#define TLD(dst, b) do { _Pragma("unroll") for (int j = 0; j < 32; ++j) dst[j] = wp[(size_t)(32 * (b) + j) * N]; asm volatile("" ::: "memory"); } while (0)
#define TST(src, b) do { _Pragma("unroll") for (int j = 0; j < 8; ++j) *(LAS unsigned*)(scr + lane * 132 + 4 * (8 * (b) + j)) = pk4_fp8(src[4 * j] * sc, src[4 * j + 1] * sc, src[4 * j + 2] * sc, src[4 * j + 3] * sc); asm volatile("" ::: "memory"); } while (0)
    TLD(va, 0); TLD(vb, 1); TST(va, 0); TLD(va, 2); TST(vb, 1); TLD(vb, 3); TST(va, 2); TST(vb, 3);
#undef TLD
#undef TST
    LDS_WAIT(); asm volatile("" ::: "memory");
    const int c = lane & 7;
#pragma unroll
    for (int j = 0; j < 8; ++j) { const int nn = (lane >> 3) + 8 * j; const LAS unsigned* sp = (const LAS unsigned*)(scr + nn * 132 + 16 * c);
        u32x4 o; o.x = sp[0]; o.y = sp[1]; o.z = sp[2]; o.w = sp[3];
        const int row = rowbase + (ILV ? 64 * (nn >> 5) + (nn & 31) : nn);
        *(GAS u32x4*)(WT + (size_t)row * DP + k0 + 16 * c) = o; }
    LDS_WAIT(); asm volatile("" ::: "memory");
}
__device__ __forceinline__ void conv_phase(const Frame& F, int l) {
    const ArgsP a_ = F.ap;
#define a (*a_)
    LAS float* scr = (LAS float*)(F.lds + F.wave * 16384);
    unsigned char* ws = F.ws;
    const int gw = F.bid * NWAVES + F.wave, NGW = F.G * NWAVES;
    LAS unsigned char* scr8 = F.lds + F.wave * 16384;
    constexpr int I_INB = 32 * 104, I_IN8 = 16 * 96, I_UA = 4 * 32, I_UB = 8 * 32, I_UC = 4 * 32, I_O = 16 * 32, I_EG = 32 * 256, I_EU = 32 * 256, I_ED = 32 * 256;
    constexpr int NITEMS = I_INB + I_IN8 + I_UA + I_UB + I_UC + I_O + I_EG + I_EU + I_ED;
    static_assert(FP8_IN == 1 && FP8_MOE == 1 && FP8_O == 1, "conv_phase item lists are written for the fp8 build");
    for (int it = gw; it < NITEMS; it += NGW) {
        int r = it;
        if (r < I_EG + I_EU) {
            const int isup = r >= I_EG; if (isup) r -= I_EG;
            const int e = r >> 8, q = r & 255, kb = q >> 4, nb = q & 15, n0 = 64 * nb;
            const float* src = a.in[isup ? I_W_EU : I_W_EG] + ((size_t)l * NEXP + e) * (size_t)D * FF;
            transpose_item_fp8<true>(src, D, FF, ws + WS_W13 + (size_t)e * 2048 * D, kb, nb, 256 * (n0 >> 7) + 64 * ((n0 & 127) >> 5) + 32 * isup, scr8, F.lane); continue; }
        r -= I_EG + I_EU;
        if (r < I_ED) { const int e = r >> 8, q = r & 255, kb = q >> 5, nb = q & 31;
            transpose_item_fp8<false>(a.in[I_W_ED] + ((size_t)l * NEXP + e) * (size_t)FF * D, FF, D, ws + WS_WD + (size_t)e * 2048 * FF, kb, nb, 64 * nb, scr8, F.lane); continue; }
        r -= I_ED;
        if (r < I_IN8) { const int kb = r / 96, nb = r % 96;
            transpose_item_fp8<false>(a.in[I_W_IN] + (size_t)l * D * PW, D, PW, ws + WS_WIN8, kb, nb + 52, 64 * nb, scr8, F.lane); continue; }
        r -= I_IN8;
        if (r < I_INB) { const int kb = r / 104, nb = r % 104;
            transpose_item(a.in[I_W_IN] + (size_t)l * D * PW, D, PW, (bf16_t*)(ws + WS_WIN), kb, nb, 32 * nb, scr, F.lane, a.in[I_NORM_MIX] + (size_t)l * D); continue; }
        r -= I_INB;
        if (r < I_UA) { transpose_item_fp8<false>(a.in[I_W_UP_A] + (size_t)l * 512 * D, 512, D, ws + WS_WUPA, r / 32, r % 32, 64 * (r % 32), scr8, F.lane, D); continue; } r -= I_UA;
        if (r < I_UB) { transpose_item_fp8<false>(a.in[I_W_UP_B] + (size_t)l * 1024 * D, 1024, D, ws + WS_WUPA + 512, r / 32, r % 32, 64 * (r % 32), scr8, F.lane, D); continue; } r -= I_UB;
        if (r < I_UC) { transpose_item_fp8<false>(a.in[I_W_UP_C] + (size_t)l * 512 * D, 512, D, ws + WS_WUPA + 1536, r / 32, r % 32, 64 * (r % 32), scr8, F.lane, D); continue; } r -= I_UC;
        transpose_item_fp8<false>(a.in[I_W_O] + (size_t)l * D * D, D, D, ws + WS_WO, r / 32, r % 32, 64 * (r % 32), scr8, F.lane);
    }
    const int gt = F.bid * NTHR + F.tid, NGT = F.G * NTHR;
    { bf16_t* wr = (bf16_t*)(ws + WS_WR); const float* wg = a.in[I_W_RG] + (size_t)l * D * 4; const float* we = a.in[I_W_RE] + (size_t)l * D * 32;
      const float* gf = a.in[I_NORM_FFN] + (size_t)l * D;
      for (int i = gt; i < 256 * D; i += NGT) { const int n = i >> 11, k = i & 2047; const float v = n < 4 ? wg[k * 4 + n] : (n < 36 ? we[k * 32 + (n - 4)] : 0.f); wr[i] = (bf16_t)f2bf(v * gf[k]); } }
    { bf16_t* pw = (bf16_t*)(ws + WS_POOLW); const float* src = a.in[I_POOL_W] + (size_t)l * 4 * 128 * 128;
      for (int i = gt; i < 4 * 128 * 128; i += NGT) { const int g = i >> 14, e = (i >> 7) & 127, c = i & 127; pw[i] = (bf16_t)f2bf(src[(g * 128 + c) * 128 + e]); } }
    if (l == 0) {
        f32x2* rt = (f32x2*)(ws + WS_ROPE);
        for (int i = gt; i < SEQ * 32; i += NGT) {
            const int pos = i >> 5, fi = i & 31; const float ang = (float)pos * a.inv_freq[fi];
            const double x = (double)ang; const double kq = __builtin_rint(x * 0.63661977236758134308);
            double r = __builtin_fma(-kq, 1.57079632679489655800e+00, x); r = __builtin_fma(-kq, 6.12323399573676603587e-17, r);
            const double r2 = r * r;
            double s = -1.0 / 1307674368000.0; s = s * r2 + 1.0 / 6227020800.0; s = s * r2 - 1.0 / 39916800.0; s = s * r2 + 1.0 / 362880.0; s = s * r2 - 1.0 / 5040.0; s = s * r2 + 1.0 / 120.0; s = s * r2 - 1.0 / 6.0; s = s * r2 * r + r;
            double c = 1.0 / 20922789888000.0; c = c * r2 - 1.0 / 87178291200.0; c = c * r2 + 1.0 / 479001600.0; c = c * r2 - 1.0 / 3628800.0; c = c * r2 + 1.0 / 40320.0; c = c * r2 - 1.0 / 720.0; c = c * r2 + 1.0 / 24.0; c = c * r2 - 0.5; c = c * r2 + 1.0;
            const int qd = (int)((long long)kq & 3);
            const double sn = (qd == 0) ? s : (qd == 1) ? c : (qd == 2) ? -s : -c;
            const double cs = (qd == 0) ? c : (qd == 1) ? -s : (qd == 2) ? -c : s;
            rt[i] = (f32x2){(float)cs, (float)sn};
        }
    }
#undef a
}

__device__ __forceinline__ void build_blkbase(const Frame& F, const gu32* cnt) {
    LAS int* bb = (LAS int*)(F.lds + MISC_OFF + 256);
    __syncthreads();
    if (F.tid < 33) { int s = 0; for (int e = 0; e < F.tid; ++e) s += (int)((__hip_atomic_load(cnt + e, RLX_AGENT) + 255u) >> 8); bb[F.tid] = s; }
    __syncthreads();
}
template <int MODE>
__device__ __forceinline__ void norm_phase(const Frame& F, const float* src, float* out, const float* gain, const gu32* cnt_prev) {
    const int gw = F.bid * NWAVES + F.wave, NGW = F.G * NWAVES;
    const LAS int* bb = (const LAS int*)(F.lds + MISC_OFF + 256);
    if (MODE >= 2) build_blkbase(F, cnt_prev);
    unsigned char* H8 = F.ws + WS_H8; float* RS = (float*)(F.ws + (MODE == 1 ? WS_RS2 : WS_RS1));
    bf16_t* X = (bf16_t*)(F.ws + WS_X);
    const unsigned char* Y = F.ws + WS_Y;
    const int* tokr = (const int*)(F.ws + WS_TOKR);
    f32x4 g[8];
    if (MODE != 3) {
#pragma unroll
        for (int j = 0; j < 8; ++j) g[j] = *(const f32x4*)(gain + 4 * F.lane + 256 * j);
    }
    for (int m = gw; m < T; m += NGW) {
        f32x4 v[8];
        if (MODE == 0) { const float* xr = src + (size_t)m * D + 4 * F.lane; bf16_t* xw = X + (size_t)m * D + 4 * F.lane;
#pragma unroll
            for (int j = 0; j < 8; ++j) { const f32x4 t4 = *(const f32x4*)(xr + 256 * j); u32x2 w; w.x = cvt_pk_bf16(t4[0], t4[1]); w.y = cvt_pk_bf16(t4[2], t4[3]); *(u32x2*)(xw + 256 * j) = w;
                v[j] = (f32x4){bflo(w.x), bfhi(w.x), bflo(w.y), bfhi(w.y)}; } }
        else { const bf16_t* xr = X + (size_t)m * D + 4 * F.lane;
#pragma unroll
            for (int j = 0; j < 8; ++j) { const u32x2 r = *(const u32x2*)(xr + 256 * j); v[j] = (f32x4){bflo(r.x), bfhi(r.x), bflo(r.y), bfhi(r.y)}; } }
        if (MODE >= 2) {
            const int e0 = tokr[m * 4 + 0], r0 = tokr[m * 4 + 1], e1 = tokr[m * 4 + 2], r1 = tokr[m * 4 + 3];
            const unsigned char* y0 = Y + ((size_t)bb[e0] * 256 + r0) * D + 4 * F.lane; const unsigned char* y1 = Y + ((size_t)bb[e1] * 256 + r1) * D + 4 * F.lane;
            constexpr float ysc = 1.0f / (float)(1 << F8_YSH);
#pragma unroll
            for (int j = 0; j < 8; ++j) { const int a = *(const int*)(y0 + 256 * j), b = *(const int*)(y1 + 256 * j);
                v[j][0] += (__builtin_amdgcn_cvt_f32_fp8(a, 0) + __builtin_amdgcn_cvt_f32_fp8(b, 0)) * ysc; v[j][1] += (__builtin_amdgcn_cvt_f32_fp8(a, 1) + __builtin_amdgcn_cvt_f32_fp8(b, 1)) * ysc;
                v[j][2] += (__builtin_amdgcn_cvt_f32_fp8(a, 2) + __builtin_amdgcn_cvt_f32_fp8(b, 2)) * ysc; v[j][3] += (__builtin_amdgcn_cvt_f32_fp8(a, 3) + __builtin_amdgcn_cvt_f32_fp8(b, 3)) * ysc; }
            if (MODE == 3) { float* orow = out + (size_t)m * D + 4 * F.lane;
#pragma unroll
                for (int j = 0; j < 8; ++j) *(f32x4*)(orow + 256 * j) = v[j]; }
            else { bf16_t* xw = X + (size_t)m * D + 4 * F.lane;
#pragma unroll
                for (int j = 0; j < 8; ++j) { u32x2 w; w.x = cvt_pk_bf16(v[j][0], v[j][1]); w.y = cvt_pk_bf16(v[j][2], v[j][3]); *(u32x2*)(xw + 256 * j) = w;
                    v[j] = (f32x4){bflo(w.x), bfhi(w.x), bflo(w.y), bfhi(w.y)}; } }
        }
        if (MODE != 3) {
            float s = 0.f;
#pragma unroll
            for (int j = 0; j < 8; ++j) s += (v[j][0] * v[j][0] + v[j][1] * v[j][1]) + (v[j][2] * v[j][2] + v[j][3] * v[j][3]);
            const float rstd = 1.0f / sqrtf(wave_sum(s) * (1.0f / D) + RMS_EPS);
            if (F.lane == 0) RS[m] = rstd;
#pragma unroll
            for (int j = 0; j < 8; ++j) { const float h0 = v[j][0] * rstd * g[j][0], h1 = v[j][1] * rstd * g[j][1], h2 = v[j][2] * rstd * g[j][2], h3 = v[j][3] * rstd * g[j][3];
                constexpr float sc = (float)(1 << F8_HSH);
                *(unsigned*)(H8 + (size_t)m * D + 4 * F.lane + 256 * j) = pk4_fp8(h0 * sc, h1 * sc, h2 * sc, h3 * sc); }
        }
    }
}

__device__ __forceinline__ void qk_norm_rope8(bf16_t* p, const u32x4 raw, const float (&g8)[8], const f32x4 (&cs)[4], int s, float (&y)[8]) {
    float v[8] = {bflo(raw.x), bfhi(raw.x), bflo(raw.y), bfhi(raw.y), bflo(raw.z), bfhi(raw.z), bflo(raw.w), bfhi(raw.w)};
    float ss = 0.f;
#pragma unroll
    for (int i = 0; i < 8; ++i) ss += v[i] * v[i];
    ss += __shfl_xor(ss, 1); ss += __shfl_xor(ss, 2); ss += __shfl_xor(ss, 4);
    const float rstd = 1.0f / sqrtf(ss * (1.0f / 64.0f) + RMS_EPS);
    const float sgn = (s < 4) ? -1.f : 1.f;
#pragma unroll
    for (int i = 0; i < 8; ++i) v[i] = v[i] * rstd * g8[i];
#pragma unroll
    for (int i2 = 0; i2 < 4; ++i2) {
        const float p0 = __shfl_xor(v[2 * i2], 4), p1 = __shfl_xor(v[2 * i2 + 1], 4);
        y[2 * i2] = v[2 * i2] * cs[i2][0] + sgn * p0 * cs[i2][1]; y[2 * i2 + 1] = v[2 * i2 + 1] * cs[i2][2] + sgn * p1 * cs[i2][3]; }
    u32x4 o; o.x = pk2(y[0], y[1]); o.y = pk2(y[2], y[3]); o.z = pk2(y[4], y[5]); o.w = pk2(y[6], y[7]);
    *(u32x4*)p = o;
}
__device__ __forceinline__ void prep_phase(const Frame& F, int l) {
    const ArgsP a_ = F.ap;
#define a (*a_)
    bf16_t* PROJ = (bf16_t*)(F.ws + WS_PROJ);
    const f32x2* rope = (const f32x2*)(F.ws + WS_ROPE);
    float* KMP = (float*)(F.ws + WS_KMP);
    unsigned char* YA = F.ws + WS_YA;
    const bf16_t* POOLW = (const bf16_t*)(F.ws + WS_POOLW);
    const float* pscale = a.in[I_POOL_SCALE] + (size_t)l * 512;
    LAS bf16_t* PT = (LAS bf16_t*)F.lds;
    const int grp = F.tid >> 3, s = F.tid & 7;
    for (int unit = F.bid; unit < T / 128; unit += F.G) {
        const int b = unit >> 7, t0 = (unit & 127) * 128; const size_t tb = (size_t)b * SEQ + t0;
        {
            f32x4 cs[2][4];
#pragma unroll
            for (int it = 0; it < 2; ++it) { const f32x4* rr = (const f32x4*)(rope + (size_t)(t0 + grp + 64 * it) * 32 + 8 * (s & 3));
#pragma unroll
                for (int i2 = 0; i2 < 4; ++i2) cs[it][i2] = rr[i2]; }
            const float* gq = a.in[I_SWA_QN] + (size_t)l * 64 + 8 * s; const float* gk = a.in[I_SWA_KN] + (size_t)l * 64 + 8 * s; const float* gm = a.in[I_MOBA_QN] + (size_t)l * 64 + 8 * s;
            float g8q[8], g8k[8], g8m[8];
#pragma unroll
            for (int i = 0; i < 8; ++i) { g8q[i] = gq[i]; g8k[i] = gk[i]; g8m[i] = gm[i]; }
#pragma unroll 1
            for (int h0 = 0; h0 < 28; h0 += 7) {
                u32x4 raw[7][2]; bf16_t* ptr[7][2];
#pragma unroll
                for (int k = 0; k < 7; ++k) { const int hs = h0 + k;
                    const int col = hs < 16 ? QB_OFF + 64 * hs : (hs < 18 ? KB_OFF + 64 * (hs - 16) : QM_OFF + 64 * (hs - 18));
#pragma unroll
                    for (int it = 0; it < 2; ++it) { ptr[k][it] = PROJ + (tb + grp + 64 * it) * PW + col + 8 * s; if (hs < 26) raw[k][it] = *(const u32x4*)ptr[k][it]; } }
                asm volatile("" ::: "memory");
#pragma unroll
                for (int k = 0; k < 7; ++k) { const int hs = h0 + k;
                    if (hs < 26) {
#pragma unroll
                        for (int it = 0; it < 2; ++it) { float y[8];
                            if (hs < 16) qk_norm_rope8(ptr[k][it], raw[k][it], g8q, cs[it], s, y); else if (hs < 18) qk_norm_rope8(ptr[k][it], raw[k][it], g8k, cs[it], s, y); else qk_norm_rope8(ptr[k][it], raw[k][it], g8m, cs[it], s, y); } } }
            }
        }
        {
            const int h = F.wave, gi = F.lane >> 3;
            const float* gp = a.in[I_MOBA_KN] + (size_t)l * 64 + 8 * s;
            float g8[8], acc8[8];
#pragma unroll
            for (int i = 0; i < 8; ++i) { g8[i] = gp[i]; acc8[i] = 0.f; }
#pragma unroll 1
            for (int it0 = 0; it0 < 16; it0 += 4) {
                u32x4 raw[4]; f32x4 cs[4][4]; bf16_t* ptr[4];
#pragma unroll
                for (int k = 0; k < 4; ++k) { const int tok = gi + 8 * (it0 + k); ptr[k] = PROJ + (tb + tok) * PW + KM_OFF + 64 * h + 8 * s; raw[k] = *(const u32x4*)ptr[k];
                    const f32x4* rr = (const f32x4*)(rope + (size_t)(t0 + tok) * 32 + 8 * (s & 3));
#pragma unroll
                    for (int i2 = 0; i2 < 4; ++i2) cs[k][i2] = rr[i2]; }
                asm volatile("" ::: "memory");
#pragma unroll
                for (int k = 0; k < 4; ++k) { float y[8]; qk_norm_rope8(ptr[k], raw[k], g8, cs[k], s, y);
#pragma unroll
                    for (int i = 0; i < 8; ++i) acc8[i] += y[i]; }
            }
#pragma unroll
            for (int i = 0; i < 8; ++i) { acc8[i] += __shfl_xor(acc8[i], 8); acc8[i] += __shfl_xor(acc8[i], 16); acc8[i] += __shfl_xor(acc8[i], 32); }
            if (gi == 0) { float* kp = KMP + ((size_t)(b * 128 + (t0 >> 7)) * 8 + h) * 64 + 8 * s;
#pragma unroll
                for (int i = 0; i < 8; ++i) kp[i] = acc8[i]; }
        }
#pragma unroll 1
        for (int g = 0; g < 4; ++g) {
            const int w = 2 << g;
            __syncthreads();
#pragma unroll
            for (int k = 0; k < 4; ++k) {
                const int idx = F.tid + NTHR * k, tok = idx >> 4, ch = idx & 15; const int pos = t0 + tok; const int cnt = (pos + 1 < w) ? pos + 1 : w;
                const bf16_t* xp = PROJ + (tb + tok) * PW + XA_OFF + 128 * g + 8 * ch;
                float sum[8], x0[8];
#pragma unroll
                for (int i = 0; i < 8; ++i) sum[i] = 0.f;
#pragma unroll 2
                for (int i = 0; i < w; i += 2) {
                    u32x4 r0 = {0u, 0u, 0u, 0u}, r1 = {0u, 0u, 0u, 0u};
                    if (i < cnt) r0 = *(const u32x4*)(xp - (size_t)i * PW);
                    if (i + 1 < cnt) r1 = *(const u32x4*)(xp - (size_t)(i + 1) * PW);
                    const float v0[8] = {bflo(r0.x), bfhi(r0.x), bflo(r0.y), bfhi(r0.y), bflo(r0.z), bfhi(r0.z), bflo(r0.w), bfhi(r0.w)};
                    const float v1[8] = {bflo(r1.x), bfhi(r1.x), bflo(r1.y), bfhi(r1.y), bflo(r1.z), bfhi(r1.z), bflo(r1.w), bfhi(r1.w)};
#pragma unroll
                    for (int q = 0; q < 8; ++q) { sum[q] += v0[q] + v1[q]; if (i == 0) x0[q] = v0[q]; }
                }
                const float rc = 1.0f / (float)cnt;
                u32x4 o; o.x = pk2(sum[0] * rc - x0[0], sum[1] * rc - x0[1]); o.y = pk2(sum[2] * rc - x0[2], sum[3] * rc - x0[3]);
                o.z = pk2(sum[4] * rc - x0[4], sum[5] * rc - x0[5]); o.w = pk2(sum[6] * rc - x0[6], sum[7] * rc - x0[7]);
                *(LAS u32x4*)(PT + tok * 136 + 8 * ch) = o;
            }
            __syncthreads();
            const int r16 = F.lane & 15, kg = F.lane >> 4;
            bf16x8 af[4];
#pragma unroll
            for (int ks = 0; ks < 4; ++ks) af[ks] = *(const LAS bf16x8*)(PT + (16 * F.wave + r16) * 136 + 32 * ks + 8 * kg);
#pragma unroll
            for (int nt = 0; nt < 8; ++nt) {
                f32x4 acc = {0.f, 0.f, 0.f, 0.f};
#pragma unroll
                for (int ks = 0; ks < 4; ++ks) { const bf16x8 bfr = *(const bf16x8*)(POOLW + ((size_t)g * 128 + 16 * nt + r16) * 128 + 32 * ks + 8 * kg);
                    acc = __builtin_amdgcn_mfma_f32_16x16x32_bf16(bfr, af[ks], acc, 0, 0, 0); }
                const int e0 = 128 * g + 16 * nt + 4 * kg; const f32x4 sc = *(const f32x4*)(pscale + e0);
                constexpr float ms = (float)(1 << F8_MSH);
                *(unsigned*)(YA + (tb + 16 * F.wave + r16) * 2048 + e0) = pk4_fp8(acc[0] * sc[0] * ms, acc[1] * sc[1] * ms, acc[2] * sc[2] * ms, acc[3] * sc[3] * ms);
            }
        }
        __syncthreads();
    }
#undef a
}

typedef short v4i16_t __attribute__((ext_vector_type(4)));
__device__ __forceinline__ s16x4 vtr(const LAS unsigned char* p) { return __builtin_bit_cast(s16x4, __builtin_amdgcn_ds_read_tr16_b64_v4i16((LAS v4i16_t*)p)); }
__device__ __forceinline__ void load_kv256(LAS unsigned char* kb, LAS unsigned char* vb, const bf16_t* ksrc, const bf16_t* vsrc, int tid, int zero_rows) {
#pragma unroll
    for (int it = 0; it < 4; ++it) {
        const int i = tid + NTHR * it, key = i >> 3, c = i & 7;
        u32x4 kv = {0u, 0u, 0u, 0u}, vv = {0u, 0u, 0u, 0u};
        if (key >= zero_rows) { kv = *(const u32x4*)(ksrc + (size_t)key * PW + 8 * c); vv = *(const u32x4*)(vsrc + (size_t)key * PW + 8 * c); }
        *(LAS u32x4*)(kb + c * 4096 + ((key ^ c) << 4)) = kv;
        *(LAS u32x4*)(vb + (c >> 2) * 16384 + key * 64 + (c & 3) * 16) = vv;
    }
}
template <int NT, int MASK>
__device__ __forceinline__ void attn_step(const LAS unsigned char* kb, const LAS unsigned char* vb, const int kt0, const bf16x8 (&q)[4], f32x16 (&o)[2], float& m, float& l,
                                          const int lane, const int qt, const bool blk0) {
    const int r32 = lane & 31, hi = lane >> 5;
    f32x16 p[NT];
#pragma unroll
    for (int i = 0; i < NT; ++i)
#pragma unroll
        for (int r = 0; r < 16; ++r) p[i][r] = 0.f;
#pragma unroll
    for (int s = 0; s < 4; ++s)
#pragma unroll
        for (int i = 0; i < NT; ++i) { const int key = 32 * (kt0 + i) + r32, ch = 2 * s + hi;
            const bf16x8 kf = *(const LAS bf16x8*)(kb + ch * 4096 + ((key ^ ch) << 4));
            p[i] = __builtin_amdgcn_mfma_f32_32x32x16_bf16(kf, q[s], p[i], 0, 0, 0); }
    const int qw = 32 * qt + r32;
    float mx = -INFINITY;
#pragma unroll
    for (int i = 0; i < NT; ++i) {
        if (MASK != 0) {
#pragma unroll
            for (int r = 0; r < 16; ++r) { const int kw = 32 * (kt0 + i) + (r & 3) + 8 * (r >> 2) + 4 * hi;
                const bool ok = (MASK == 1) ? (kw > qw && kw <= qw + 128 && (!blk0 || kw >= 128)) : (kw <= qw);
                p[i][r] = ok ? p[i][r] : -INFINITY; }
        }
#pragma unroll
        for (int r = 0; r < 16; r += 2) mx = fmaxf(fmaxf(mx, p[i][r]), p[i][r + 1]);
    }
    mx *= C2;
    mx = fmaxf(mx, __shfl_xor(mx, 32));
    const float mnew = fmaxf(m, mx);
    if (__any(mnew != m)) {
        const float alpha = __builtin_amdgcn_exp2f(m - mnew); m = mnew; l *= alpha;
#pragma unroll
        for (int r = 0; r < 16; ++r) { o[0][r] *= alpha; o[1][r] *= alpha; }
    }
    const float nm = -m;
    float ps = 0.f;
#pragma unroll
    for (int i = 0; i < NT; ++i)
#pragma unroll
        for (int r = 0; r < 16; ++r) { const float e = __builtin_amdgcn_exp2f(__builtin_fmaf(p[i][r], C2, nm)); p[i][r] = e; ps += e; }
    l += ps;
    const int vlane = (4 * hi + ((lane & 15) >> 2)) * 64 + ((lane >> 4) & 1) * 32 + (lane & 3) * 8;
#pragma unroll
    for (int i = 0; i < NT; ++i) {
        u32x4 pw[2];
#pragma unroll
        for (int s2 = 0; s2 < 2; ++s2) { pw[s2].x = cvt_pk_bf16(p[i][8 * s2 + 0], p[i][8 * s2 + 1]); pw[s2].y = cvt_pk_bf16(p[i][8 * s2 + 2], p[i][8 * s2 + 3]);
            pw[s2].z = cvt_pk_bf16(p[i][8 * s2 + 4], p[i][8 * s2 + 5]); pw[s2].w = cvt_pk_bf16(p[i][8 * s2 + 6], p[i][8 * s2 + 7]); }
#pragma unroll
        for (int s2 = 0; s2 < 2; ++s2)
#pragma unroll
            for (int d0 = 0; d0 < 2; ++d0) {
                const LAS unsigned char* vp = vb + d0 * 16384 + (32 * (kt0 + i) + 16 * s2) * 64 + vlane;
                const s16x4 lo = vtr(vp), hi4 = vtr(vp + 512);
                const bf16x8 vf = {lo[0], lo[1], lo[2], lo[3], hi4[0], hi4[1], hi4[2], hi4[3]};
                o[d0] = __builtin_amdgcn_mfma_f32_32x32x16_bf16(vf, __builtin_bit_cast(bf16x8, pw[s2]), o[d0], 0, 0, 0); }
    }
}

#define SELIDX(t, h) ((((size_t)(t) >> 14) * 8 + (size_t)(h)) * SEQ + ((size_t)(t) & (SEQ - 1)))
__device__ __forceinline__ void gate_unit(const Frame& F, int b, int j, int hp) {
    const bf16_t* PROJ = (const bf16_t*)(F.ws + WS_PROJ);
    const float* KMP = (const float*)(F.ws + WS_KMP);
    unsigned* SEL = (unsigned*)(F.ws + WS_SEL);
    LAS unsigned char* km = F.lds;
    __syncthreads();
    for (int i = F.tid; i < j * 128; i += NTHR) { const int n = i >> 7, rem = i & 127, hh = rem >> 6, d = rem & 63, h2 = hp * 2 + hh;
        const float v = (KMP[((size_t)(b * 128 + 2 * n) * 8 + h2) * 64 + d] + KMP[((size_t)(b * 128 + 2 * n + 1) * 8 + h2) * 64 + d]) * (1.0f / 256.0f);
        const unsigned vh = f2bf(v); const float rest = v - __builtin_bit_cast(float, vh << 16);
        LAS bf16_t* p = (LAS bf16_t*)(km + hh * 16384 + (d >> 3) * 1024 + n * 16 + (d & 7) * 2);
        p[0] = (bf16_t)vh; p[4096] = (bf16_t)f2bf(rest); }
    __syncthreads();
    const int lane = F.lane, r32 = lane & 31, hi = lane >> 5, hh = F.wave >> 2, h = hp * 2 + hh;
    const LAS unsigned char* kmh = km + hh * 16384;
    const int ngrp = (j + 31) >> 5;
#pragma unroll 1
    for (int tile = 0; tile < 2; ++tile) {
        const size_t t = (size_t)b * SEQ + 256 * j + (F.wave & 3) * 64 + 32 * tile + r32;
        bf16x8 q[4];
#pragma unroll
        for (int s = 0; s < 4; ++s) q[s] = *(const bf16x8*)(PROJ + t * PW + QM_OFF + 64 * h + 16 * s + 8 * hi);
        float v0 = -INFINITY, v1 = -INFINITY, v2 = -INFINITY; unsigned i0 = 255u, i1 = 255u, i2 = 255u;
#pragma unroll 1
        for (int g = 0; g < ngrp; ++g) {
            f32x16 p;
#pragma unroll
            for (int r = 0; r < 16; ++r) p[r] = 0.f;
#pragma unroll
            for (int s = 0; s < 4; ++s)
#pragma unroll
                for (int part = 0; part < 2; ++part) { const bf16x8 kf = *(const LAS bf16x8*)(kmh + part * 8192 + (2 * s + hi) * 1024 + ((32 * g + r32) << 4));
                    p = __builtin_amdgcn_mfma_f32_32x32x16_bf16(kf, q[s], p, 0, 0, 0); }
#pragma unroll
            for (int r = 0; r < 16; ++r) { const int n = 32 * g + (r & 3) + 8 * (r >> 2) + 4 * hi;
                const float dv = (n < j) ? p[r] : -INFINITY;
                if (dv > v0) { v2 = v1; i2 = i1; v1 = v0; i1 = i0; v0 = dv; i0 = (unsigned)n; }
                else if (dv > v1) { v2 = v1; i2 = i1; v1 = dv; i1 = (unsigned)n; }
                else if (dv > v2) { v2 = dv; i2 = (unsigned)n; } }
        }
        const float w0 = __shfl_xor(v0, 32), w1 = __shfl_xor(v1, 32), w2 = __shfl_xor(v2, 32);
        const unsigned k0 = __shfl_xor(i0, 32), k1 = __shfl_xor(i1, 32), k2 = __shfl_xor(i2, 32);
#define GINS(dv, n) do { const float dv_ = (dv); const unsigned n_ = (n); \
            if (dv_ > v0 || (dv_ == v0 && n_ < i0)) { v2 = v1; i2 = i1; v1 = v0; i1 = i0; v0 = dv_; i0 = n_; } \
            else if (dv_ > v1 || (dv_ == v1 && n_ < i1)) { v2 = v1; i2 = i1; v1 = dv_; i1 = n_; } \
            else if (dv_ > v2 || (dv_ == v2 && n_ < i2)) { v2 = dv_; i2 = n_; } } while (0)
        GINS(w0, k0); GINS(w1, k1); GINS(w2, k2);
#undef GINS
        if (hi == 0) SEL[SELIDX(t, h)] = i0 | (i1 << 8) | (i2 << 16) | 0xFF000000u;
    }
}
__device__ __forceinline__ void swa_unit(const Frame& F, int l, int b, int g, int blk) {
    const bf16_t* PROJ = (const bf16_t*)(F.ws + WS_PROJ);
    unsigned char* YB = F.ws + WS_YA + 512;
    LAS unsigned char* kb = F.lds; LAS unsigned char* vb = F.lds + 32768;
    const size_t tb = (size_t)b * SEQ + (size_t)blk * 128;
    __syncthreads();
    { const long long w0 = (long long)tb - 128;
      load_kv256(kb, vb, PROJ + w0 * PW + KB_OFF + 64 * g, PROJ + w0 * PW + VB_OFF + 64 * g, F.tid, blk == 0 ? 128 : 0); }
    __syncthreads();
    const int head = g * 8 + F.wave, lane = F.lane, r32 = lane & 31, hi = lane >> 5;
    const float sink2 = F.ap->in[I_SWA_SINKS][l * 16 + head] * LOG2E;
    for (int qt = 0; qt < 4; ++qt) {
        const size_t tq = tb + 32 * qt + r32;
        bf16x8 q[4];
#pragma unroll
        for (int s = 0; s < 4; ++s) q[s] = *(const bf16x8*)(PROJ + tq * PW + QB_OFF + 64 * head + 16 * s + 8 * hi);
        f32x16 o[2];
#pragma unroll
        for (int r = 0; r < 16; ++r) { o[0][r] = 0.f; o[1][r] = 0.f; }
        float m = sink2, lsum = (hi == 0) ? 1.0f : 0.0f;
        if (blk == 0) {
            attn_step<2, 1>(kb, vb, qt, q, o, m, lsum, lane, qt, true);
            attn_step<2, 1>(kb, vb, qt + 2, q, o, m, lsum, lane, qt, true);
            attn_step<1, 1>(kb, vb, qt + 4, q, o, m, lsum, lane, qt, true);
        } else {
            attn_step<1, 1>(kb, vb, qt, q, o, m, lsum, lane, qt, false);
            attn_step<2, 0>(kb, vb, qt + 1, q, o, m, lsum, lane, qt, false);
            attn_step<1, 0>(kb, vb, qt + 3, q, o, m, lsum, lane, qt, false);
            attn_step<1, 1>(kb, vb, qt + 4, q, o, m, lsum, lane, qt, false);
        }
        lsum += __shfl_xor(lsum, 32);
        const float inv = (float)(1 << F8_MSH) / lsum;
        unsigned char* op = YB + tq * 2048 + 64 * head + 4 * hi;
#pragma unroll
        for (int d0 = 0; d0 < 2; ++d0)
#pragma unroll
            for (int g4 = 0; g4 < 4; ++g4) *(unsigned*)(op + 32 * d0 + 8 * g4) = pk4_fp8(o[d0][4 * g4] * inv, o[d0][4 * g4 + 1] * inv, o[d0][4 * g4 + 2] * inv, o[d0][4 * g4 + 3] * inv);
    }
}
__device__ __forceinline__ void gate_swa_phase(const Frame& F, int l) {
    for (int u = F.bid; u < 1024; u += F.G) {
        if (u < 512) { const int idx = u >> 2, hp = u & 3, b = idx >> 6, jj = idx & 63, j = b == 0 ? jj : 63 - jj; gate_unit(F, b, j, hp); }
        else { const int v = u - 512, b = v >> 8, g = (v >> 7) & 1, blk = v & 127; swa_unit(F, l, b, g, blk); }
    }
    __syncthreads();
}

__device__ __forceinline__ void moba_sel_phase(const Frame& F, int l, int rep) {
    const bf16_t* PROJ = (const bf16_t*)(F.ws + WS_PROJ);
    const unsigned* SEL = (const unsigned*)(F.ws + WS_SEL);
    float* ML = (float*)(F.ws + WS_ML); bf16_t* OPART = (bf16_t*)(F.ws + WS_OPART);
    LAS unsigned char* kb = F.lds; LAS unsigned char* vb = F.lds + 32768;
    LAS unsigned* list = (LAS unsigned*)(F.lds + 65536);
    volatile LAS unsigned* misc = (volatile LAS unsigned*)(F.lds + MISC_OFF);
    const int lane = F.lane, r32 = lane & 31, hi = lane >> 5;
    for (;;) {
        __syncthreads();
        if (F.tid == 0) misc[16] = __hip_atomic_fetch_add(F.ctl + CW_Q + 64 * l + 32 * rep, 1u, RLX_AGENT);
        __syncthreads();
        const int u = (int)misc[16];
        if (u >= 63 * 16) break;
        const int bh = u & 15, n = u >> 4, b = bh >> 3, h = bh & 7;
        const size_t tbat = (size_t)b * SEQ;
        load_kv256(kb, vb, PROJ + (tbat + 256 * n) * PW + KM_OFF + 64 * h, PROJ + (tbat + 256 * n) * PW + VM_OFF + 64 * h, F.tid, 0);
        const int s_first = 256 * (n + 1);
        for (int c = s_first >> 12; c < 4; ++c) {
            __syncthreads();
            if (F.tid == 0) misc[17] = 0u;
            __syncthreads();
#pragma unroll
            for (int k = 0; k < 8; ++k) { const int sl = F.tid + NTHR * k, s = 4096 * c + sl;
                if (s >= s_first) { const unsigned w = SEL[SELIDX(tbat + s, h)];
#pragma unroll
                    for (int slot = 0; slot < 3; ++slot) if (((w >> (8 * slot)) & 255u) == (unsigned)n) { const unsigned idx = atomicAdd((unsigned*)&misc[17], 1u); list[idx] = (unsigned)sl | ((unsigned)slot << 16); } } }
            __syncthreads();
            const int count = (int)misc[17];
            const int ntile = (count + 31) >> 5;
            for (int tile = F.wave; tile < ntile; tile += NWAVES) {
                const int idx = tile * 32 + r32; const bool valid = idx < count;
                const unsigned ent = list[valid ? idx : 0];
                const int s = 4096 * c + (int)(ent & 0xffffu), slot = (int)(ent >> 16);
                const size_t tq = tbat + s;
                bf16x8 q[4];
#pragma unroll
                for (int st = 0; st < 4; ++st) q[st] = *(const bf16x8*)(PROJ + tq * PW + QM_OFF + 64 * h + 16 * st + 8 * hi);
                f32x16 o[2];
#pragma unroll
                for (int r = 0; r < 16; ++r) { o[0][r] = 0.f; o[1][r] = 0.f; }
                float m = -INFINITY, lsum = 0.f;
#pragma unroll 1
                for (int kt = 0; kt < 8; kt += 2) attn_step<2, 0>(kb, vb, kt, q, o, m, lsum, lane, 0, false);
                lsum += __shfl_xor(lsum, 32);
                if (valid) {
                    const size_t p = (tq * 8 + h) * 3 + slot;
                    if (hi == 0) { ML[p * 2] = m; ML[p * 2 + 1] = lsum; }
                    bf16_t* op = OPART + p * 64 + 4 * hi;
#pragma unroll
                    for (int d0 = 0; d0 < 2; ++d0)
#pragma unroll
                        for (int g4 = 0; g4 < 4; ++g4) { u32x2 w; w.x = cvt_pk_bf16(o[d0][4 * g4], o[d0][4 * g4 + 1]); w.y = cvt_pk_bf16(o[d0][4 * g4 + 2], o[d0][4 * g4 + 3]); *(u32x2*)(op + 32 * d0 + 8 * g4) = w; }
                }
            }
        }
    }
}
__device__ __forceinline__ void moba_own_phase(const Frame& F) {
    const bf16_t* PROJ = (const bf16_t*)(F.ws + WS_PROJ);
    const unsigned* SEL = (const unsigned*)(F.ws + WS_SEL);
    const float* ML = (const float*)(F.ws + WS_ML); const bf16_t* OPART = (const bf16_t*)(F.ws + WS_OPART);
    unsigned char* YC = F.ws + WS_YA + 1536;
    const int lane = F.lane, r32 = lane & 31, hi = lane >> 5;
    for (int su = F.bid; su < 512; su += F.G) {
        __syncthreads();
#pragma unroll 1
        for (int which = 0; which < 2; ++which) { const int uu = su * 2 + which, bh = uu >> 6, j = uu & 63, b = bh >> 3, h = bh & 7; const size_t t0 = (size_t)b * SEQ + 256 * j;
            load_kv256(F.lds + which * 65536, F.lds + which * 65536 + 32768, PROJ + t0 * PW + KM_OFF + 64 * h, PROJ + t0 * PW + VM_OFF + 64 * h, F.tid, 0); }
        __syncthreads();
#pragma unroll 1
        for (int which = 0; which < 2; ++which) {
            const int uu = su * 2 + which, bh = uu >> 6, j = uu & 63, b = bh >> 3, h = bh & 7; const size_t t0 = (size_t)b * SEQ + 256 * j;
            const LAS unsigned char* kb = F.lds + which * 65536; const LAS unsigned char* vb = kb + 32768;
            const int qt = which == 0 ? F.wave : 7 - F.wave;
            const size_t tq = t0 + 32 * qt + r32;
            bf16x8 q[4];
#pragma unroll
            for (int st = 0; st < 4; ++st) q[st] = *(const bf16x8*)(PROJ + tq * PW + QM_OFF + 64 * h + 16 * st + 8 * hi);
            f32x16 o[2];
#pragma unroll
            for (int r = 0; r < 16; ++r) { o[0][r] = 0.f; o[1][r] = 0.f; }
            float m = -INFINITY, lsum = 0.f;
            int kt = 0;
#pragma unroll 1
            for (; kt + 2 <= qt; kt += 2) attn_step<2, 0>(kb, vb, kt, q, o, m, lsum, lane, qt, false);
            if (kt < qt) attn_step<2, 2>(kb, vb, kt, q, o, m, lsum, lane, qt, false);
            else attn_step<1, 2>(kb, vb, qt, q, o, m, lsum, lane, qt, false);
            lsum += __shfl_xor(lsum, 32);
            const unsigned sw = SEL[SELIDX(tq, h)];
            float ms[3], ls[3]; float M = m;
#pragma unroll
            for (int slot = 0; slot < 3; ++slot) { const bool ok = ((sw >> (8 * slot)) & 255u) != 255u; const size_t p = (tq * 8 + h) * 3 + slot;
                ms[slot] = ok ? ML[p * 2] : -INFINITY; ls[slot] = ok ? ML[p * 2 + 1] : 0.f; M = fmaxf(M, ms[slot]); }
            const float w_own = __builtin_amdgcn_exp2f(m - M);
            float L = lsum * w_own;
#pragma unroll
            for (int r = 0; r < 16; ++r) { o[0][r] *= w_own; o[1][r] *= w_own; }
#pragma unroll
            for (int slot = 0; slot < 3; ++slot) {
                const float ws = __builtin_amdgcn_exp2f(ms[slot] - M);
                L += ls[slot] * ws;
                if (ms[slot] != -INFINITY) { const bf16_t* op = OPART + ((tq * 8 + h) * 3 + slot) * 64 + 4 * hi;
#pragma unroll
                    for (int d0 = 0; d0 < 2; ++d0)
#pragma unroll
                        for (int g4 = 0; g4 < 4; ++g4) { const u32x2 pv = *(const u32x2*)(op + 32 * d0 + 8 * g4);
                            o[d0][4 * g4] += ws * bflo(pv.x); o[d0][4 * g4 + 1] += ws * bfhi(pv.x); o[d0][4 * g4 + 2] += ws * bflo(pv.y); o[d0][4 * g4 + 3] += ws * bfhi(pv.y); } }
            }
            const float inv = (float)(1 << F8_MSH) / L;
            unsigned char* yp = YC + tq * 2048 + 64 * h + 4 * hi;
#pragma unroll
            for (int d0 = 0; d0 < 2; ++d0)
#pragma unroll
                for (int g4 = 0; g4 < 4; ++g4) *(unsigned*)(yp + 32 * d0 + 8 * g4) = pk4_fp8(o[d0][4 * g4] * inv, o[d0][4 * g4 + 1] * inv, o[d0][4 * g4 + 2] * inv, o[d0][4 * g4 + 3] * inv);
        }
    }
    __syncthreads();
}

__device__ __forceinline__ void route_phase(const Frame& F, int l) {
    const float* LOG = (const float*)(F.ws + WS_LOGITS);
    int* slot_tok = (int*)(F.ws + WS_SLOT_TOK); float* slot_w = (float*)(F.ws + WS_SLOT_W);
    int* tokr = (int*)(F.ws + WS_TOKR);
    LAS int* hist = (LAS int*)F.lds; LAS int* base = hist + 32;
    gu32* cnt = F.ctl + CW_CNT + 64 * l;
    for (int chunk = F.bid; chunk < T / 128; chunk += F.G) {
        __syncthreads();
        if (F.tid < 32) hist[F.tid] = 0;
        __syncthreads();
        int e0 = 0, e1 = 0, r0 = 0, r1 = 0; float w0 = 0.f, w1 = 0.f; const int t = chunk * 128 + F.tid;
        if (F.tid < 128) {
            const float* lg = LOG + (size_t)t * 64; const float* lg2 = lg + (size_t)T * 64;
            float gl[4]; const f32x4 g4 = *(const f32x4*)lg + *(const f32x4*)lg2; gl[0] = g4[0]; gl[1] = g4[1]; gl[2] = g4[2]; gl[3] = g4[3];
            int gs = 0; float gm = gl[0];
#pragma unroll
            for (int i = 1; i < 4; ++i) if (gl[i] > gm) { gm = gl[i]; gs = i; }
            float den = 0.f;
#pragma unroll
            for (int i = 0; i < 4; ++i) den += __expf(gl[i] - gm);
            const float pg = 1.0f / den;
            float el[8]; const f32x4 ea = *(const f32x4*)(lg + 4 + 8 * gs) + *(const f32x4*)(lg2 + 4 + 8 * gs), eb = *(const f32x4*)(lg + 8 + 8 * gs) + *(const f32x4*)(lg2 + 8 + 8 * gs);
            el[0] = ea[0]; el[1] = ea[1]; el[2] = ea[2]; el[3] = ea[3]; el[4] = eb[0]; el[5] = eb[1]; el[6] = eb[2]; el[7] = eb[3];
            int a0 = 0; float m0 = el[0];
#pragma unroll
            for (int i = 1; i < 8; ++i) if (el[i] > m0) { m0 = el[i]; a0 = i; }
            int a1 = -1; float m1 = -INFINITY;
#pragma unroll
            for (int i = 0; i < 8; ++i) if (i != a0 && el[i] > m1) { m1 = el[i]; a1 = i; }
            const float x1 = __expf(m1 - m0); const float inv = 1.0f / (1.0f + x1);
            w0 = pg * inv; w1 = pg * x1 * inv; e0 = gs * 8 + a0; e1 = gs * 8 + a1;
            r0 = atomicAdd((int*)&hist[e0], 1); r1 = atomicAdd((int*)&hist[e1], 1);
        }
        __syncthreads();
        if (F.tid < 32) { const int hc = hist[F.tid]; base[F.tid] = hc ? (int)__hip_atomic_fetch_add(cnt + F.tid, (unsigned)hc, RLX_AGENT) : 0; }
        __syncthreads();
        if (F.tid < 128) {
            r0 += base[e0]; r1 += base[e1];
            slot_tok[(size_t)e0 * CAP + r0] = t; slot_w[(size_t)e0 * CAP + r0] = w0;
            slot_tok[(size_t)e1 * CAP + r1] = t; slot_w[(size_t)e1 * CAP + r1] = w1;
            tokr[t * 4 + 0] = e0; tokr[t * 4 + 1] = r0; tokr[t * 4 + 2] = e1; tokr[t * 4 + 3] = r1;
        }
    }
    __syncthreads();
}

template <bool G1>
struct MoeSched {
    static constexpr bool GATHER = G1;
    const char* A; const char* B; const gu32* cnt; const LAS int* bb; const int* slot_tok; int Kb, G, c, nunits;
    __device__ __forceinline__ bool next(int i, pg8::Unit& u) const {
        const int L = i * G + c; if (L >= nunits) return false;
        int f = L; { const int q = nunits / 8, r = nunits % 8, xcd = f % 8, off = f / 8; f = (xcd < r ? xcd * (q + 1) : r * (q + 1) + (xcd - r) * q) + off; }
        const int cb = f >> 3; u.pn = f & 7; u.pm = cb;
        int e = 0;
#pragma unroll
        for (int st = 16; st >= 1; st >>= 1) { const int t2 = __builtin_amdgcn_readfirstlane(bb[e + st]); if (t2 <= cb) e += st; }
        const int b0 = __builtin_amdgcn_readfirstlane(bb[e]);
        const int ce = (int)__builtin_amdgcn_readfirstlane(__hip_atomic_load(cnt + e, RLX_AGENT));
        u.e = e; u.rank0 = (cb - b0) * 256; const int rem = ce - u.rank0; u.nrow = rem < 256 ? rem : 256;
        return true;
    }
    __device__ __forceinline__ const char* a_base(const pg8::Unit& u) const { return G1 ? A : A + (size_t)u.pm * 256 * Kb; }
    __device__ __forceinline__ const char* b_base(const pg8::Unit& u) const { return B + ((size_t)u.e * 2048 + (size_t)u.pn * 256) * Kb; }
    __device__ __forceinline__ unsigned gather(const pg8::Unit& u, int R) const { const int tok = (R < u.nrow) ? slot_tok[(size_t)u.e * CAP + u.rank0 + R] : 0; return (unsigned)tok * (unsigned)Kb; }
};

constexpr int PH_PER_LAYER = 13, N_PHASES = 2 * PH_PER_LAYER + 1;
#ifndef PHMASK
#define PHMASK 0xFFFFFFFFu
#endif
#define IN(k) (((PHMASK >> ((k) % PH_PER_LAYER)) & 1u) && lo <= (k) && (k) < hi)
#define SEAM(k) do { if (IN(k) && IN((k) + 1)) xcd_barrier(bar); } while (0)
#define PH_BEGIN() do { int t_ = threadIdx.x; asm volatile("" : "+v"(t_)); F.tid = t_; F.lane = t_ & 63; F.wave = __builtin_amdgcn_readfirstlane(t_ >> 6); \
        ArgsP ap_ = (ArgsP)__builtin_amdgcn_kernarg_segment_ptr(); asm volatile("" : "+s"(ap_)); F.ap = ap_; F.ws = ap_->ws; F.ctl = (gu32*)(ap_->ws + WS_CTL); } while (0)
#define REP(k) for (int rep_ = 0; rep_ < ((l == 0 && PROBE_DUP == (k)) ? 2 : 1); ++rep_)
#define AIN(i) (F.ap->in[i])
#define AOUT (F.ap->out)
#define WSB(off) (F.ws + (off))


template <int l>
__device__ __forceinline__ void layer_phases(Frame& F, const int lo, const int hi, const XcdBarrier& bar) {
        constexpr int pb = l * PH_PER_LAYER;
        if (IN(pb + 0)) REP(0) { PH_BEGIN(); if (rep_) xcd_barrier(bar);
            conv_phase(F, l);
            if (l == 0) norm_phase<0>(F, AIN(I_X), AOUT, AIN(I_NORM_MIX), nullptr);
            else norm_phase<2>(F, nullptr, AOUT, AIN(I_NORM_MIX) + (size_t)l * D, F.ctl + CW_CNT + 64 * (l - 1));
        }
        SEAM(pb + 0);
        if (IN(pb + 1)) REP(1) { PH_BEGIN(); if (rep_) xcd_barrier(bar);
            if (FP8_IN) { pg8::UnevenSched S{WSB(WS_H8), WSB(WS_WIN8), T / 256, 24, D, F.G, F.bid};
              pg8::EpiGate8 E{WSB(WS_G8A)};
              pg8::gemm_phase<pg8::EpiGate8, pg8::UnevenSched, true, true, true, 127 - F8_WSH, 127 - F8_HSH>(F.lds, D, S, E); }
            else { pg8::DenseSched S{WSB(WS_H), (const bf16_t*)WSB(WS_WIN) + (size_t)3328 * D, T / 256, 24, 2 * D, F.G, F.bid};
              pg8::EpiProj<true> E{(bf16_t*)WSB(WS_PROJ), 13};
              pg8::gemm_phase<pg8::EpiProj<true>, pg8::DenseSched, true, true>(F.lds, 2 * D, S, E); }
            PH_BEGIN();
            { pg8::DenseSched S{WSB(WS_X), WSB(WS_WIN), T / 256, 13, 2 * D, F.G, F.bid};
              pg8::EpiProj<false> E{(bf16_t*)WSB(WS_PROJ), 0, (const float*)WSB(WS_RS1)};
              pg8::gemm_phase<pg8::EpiProj<false>, pg8::DenseSched, true, true>(F.lds, 2 * D, S, E); }
        }
        SEAM(pb + 1);
        if (IN(pb + 2)) REP(2) { PH_BEGIN(); if (rep_) xcd_barrier(bar); prep_phase(F, l); }
        SEAM(pb + 2);
        if (IN(pb + 3)) REP(3) { PH_BEGIN(); if (rep_) xcd_barrier(bar); gate_swa_phase(F, l); }
        SEAM(pb + 3);
        if (IN(pb + 4)) REP(4) { PH_BEGIN(); if (rep_) xcd_barrier(bar); moba_sel_phase(F, l, rep_); }
        SEAM(pb + 4);
        if (IN(pb + 5)) REP(5) { PH_BEGIN(); if (rep_) xcd_barrier(bar); moba_own_phase(F); }
        SEAM(pb + 5);
        if (IN(pb + 6)) REP(6) { PH_BEGIN(); if (rep_) xcd_barrier(bar);
            static_assert(FP8_O == 1, "the fused up-projection writes the fp8 operand of the output projection");
            pg8::DenseSched S{WSB(WS_YA), WSB(WS_WUPA), T / 256, D / 256, D, F.G, F.bid}; pg8::EpiUpH E{WSB(WS_G8A), WSB(WS_H8)};
            pg8::gemm_phase<pg8::EpiUpH, pg8::DenseSched, true, true, true, 127 - F8_WSH, 127 - F8_MSH>(F.lds, D, S, E);
        }
        SEAM(pb + 6);
        if (IN(pb + 7)) REP(7) { PH_BEGIN(); if (rep_) xcd_barrier(bar);
            constexpr int EB = FP8_O ? 1 : 2; constexpr bool F8 = FP8_O != 0;
            pg8::DenseSched S{WSB(FP8_O ? WS_H8 : WS_MERGED), WSB(WS_WO), T / 256, D / 256, EB * D, F.G, F.bid};
            { pg8::EpiResid<false> E{nullptr, (bf16_t*)WSB(WS_X)}; pg8::gemm_phase<pg8::EpiResid<false>, pg8::DenseSched, true, true, F8, 127 - F8_WSH, 127 - F8_HSH>(F.lds, EB * D, S, E); }
        }
        SEAM(pb + 7);
        if (IN(pb + 8)) REP(8) { PH_BEGIN(); if (rep_) xcd_barrier(bar); norm_phase<1>(F, nullptr, AOUT, AIN(I_NORM_FFN) + (size_t)l * D, nullptr); }
        SEAM(pb + 8);
        if (IN(pb + 9)) REP(9) { PH_BEGIN(); if (rep_) xcd_barrier(bar);
            pg8::SplitKSched S{WSB(WS_X), WSB(WS_WR), T / 256, 2 * D, F.G, F.bid};
            pg8::EpiLogits E{(float*)WSB(WS_LOGITS), (const float*)WSB(WS_RS2), 1.0f};
            pg8::gemm_phase<pg8::EpiLogits, pg8::SplitKSched, false, true>(F.lds, 2 * D, S, E, 16);
        }
        SEAM(pb + 9);
        if (IN(pb + 10)) REP(10) { PH_BEGIN(); if (rep_) xcd_barrier(bar); route_phase(F, l); }
        SEAM(pb + 10);
        if (IN(pb + 11)) REP(11) { PH_BEGIN(); if (rep_) xcd_barrier(bar);
            build_blkbase(F, F.ctl + CW_CNT + 64 * l);
            const LAS int* bb = (const LAS int*)(F.lds + MISC_OFF + 256);
            constexpr int EB = FP8_MOE ? 1 : 2;
            MoeSched<true> S{(const char*)WSB(FP8_MOE ? WS_H8 : WS_H), (const char*)WSB(WS_W13), F.ctl + CW_CNT + 64 * l, bb, (const int*)WSB(WS_SLOT_TOK), D * EB, F.G, F.bid, __builtin_amdgcn_readfirstlane(bb[32]) * 8};
            pg8::EpiAct<FP8_MOE != 0> E{WSB(WS_ACT)};
            pg8::gemm_phase<pg8::EpiAct<FP8_MOE != 0>, MoeSched<true>, true, true, FP8_MOE != 0, 127 - F8_WSH, 127 - F8_HSH>(F.lds, D * EB, S, E);
        }
        SEAM(pb + 11);
        if (IN(pb + 12)) REP(12) { PH_BEGIN(); if (rep_) xcd_barrier(bar);
            build_blkbase(F, F.ctl + CW_CNT + 64 * l);
            const LAS int* bb = (const LAS int*)(F.lds + MISC_OFF + 256);
            constexpr int EB = FP8_MOE ? 1 : 2;
            MoeSched<false> S{(const char*)WSB(WS_ACT), (const char*)WSB(WS_WD), F.ctl + CW_CNT + 64 * l, bb, (const int*)WSB(WS_SLOT_TOK), FF * EB, F.G, F.bid, __builtin_amdgcn_readfirstlane(bb[32]) * 8};
            pg8::EpiDown E{WSB(WS_Y), (const float*)WSB(WS_SLOT_W)};
            pg8::gemm_phase<pg8::EpiDown, MoeSched<false>, true, true, FP8_MOE != 0, 127 - F8_WSH, 127 - F8_ASH>(F.lds, FF * EB, S, E);
        }
        SEAM(pb + 12);
}

__global__ void __launch_bounds__(NTHR, 2) fwd(Args kargs) {
    extern __shared__ __attribute__((aligned(16))) unsigned char lds_raw[];
    Frame F;
    F.lds = (LAS unsigned char*)lds_raw; F.ap = (ArgsP)__builtin_amdgcn_kernarg_segment_ptr(); F.ws = F.ap->ws; F.ctl = (gu32*)(F.ws + WS_CTL);
    F.tid = threadIdx.x; F.lane = F.tid & 63; F.wave = __builtin_amdgcn_readfirstlane(F.tid >> 6); F.G = gridDim.x; F.bid = blockIdx.x;
    for (int u = F.tid; u < (LDS_BYTES - MISC_OFF) / 4; u += NTHR) ((LAS unsigned*)(F.lds + MISC_OFF))[u] = 0u;
    __syncthreads();
    const int lo = kargs.ph_lo, hi = kargs.ph_hi;
    const bool fused = (hi - lo) > 1;
    XcdBarrier bar; bar.bar = (unsigned*)(F.ctl + CW_BAR); bar.x = 0; bar.st = nullptr;
    if (fused) bar = xcd_barrier_post((unsigned*)(F.ctl + CW_BAR), (volatile LAS unsigned*)(F.lds + MISC_OFF) + 8);
    layer_phases<0>(F, lo, hi, bar);
    layer_phases<1>(F, lo, hi, bar);
    if (IN(2 * PH_PER_LAYER)) { PH_BEGIN(); norm_phase<3>(F, nullptr, AOUT, nullptr, F.ctl + CW_CNT + 64 * (DEPTH - 1)); }
#undef IN
#undef SEAM
#undef PH_BEGIN
#undef AIN
#undef REP
#undef AOUT
#undef WSB
}

extern "C" void kernel_launch(void* const* d_in, const int* in_sizes, int n_in, void* d_out, int out_size, void* d_ws, size_t ws_size, hipStream_t stream) {
    static int grid = 0;
    if (grid == 0) {
        if (n_in != 20 || in_sizes[0] != T * D || out_size != T * D || ws_size < WS_END) { fprintf(stderr, "kernel_launch: unexpected shapes (n_in %d, in0 %d, out %d, ws %zu < %zu)\n", n_in, n_in > 0 ? in_sizes[0] : -1, out_size, ws_size, (size_t)WS_END); grid = -1; return; }
        int dev = 0, cus = 0, per_cu = 0;
        if (hipGetDevice(&dev) != hipSuccess || hipDeviceGetAttribute(&cus, hipDeviceAttributeMultiprocessorCount, dev) != hipSuccess) { grid = -1; return; }
        if (hipFuncSetAttribute((const void*)fwd, hipFuncAttributeMaxDynamicSharedMemorySize, LDS_BYTES) != hipSuccess) { fprintf(stderr, "kernel_launch: hipFuncSetAttribute failed\n"); grid = -1; return; }
        if (hipOccupancyMaxActiveBlocksPerMultiprocessor(&per_cu, (const void*)fwd, NTHR, LDS_BYTES) != hipSuccess || per_cu < 1) fprintf(stderr, "kernel_launch: occupancy query says %d\n", per_cu);
        (void)hipGetLastError();
        grid = cus;
    }
    if (grid < 0) return;
    (void)hipMemsetAsync((char*)d_ws + WS_CTL, 0, CTL_ZERO_BYTES, stream);
    Args a{};
    for (int i = 0; i < 20; ++i) a.in[i] = (const float*)d_in[i];
    a.out = (float*)d_out; a.ws = (unsigned char*)d_ws;
    for (int i = 0; i < 32; ++i) a.inv_freq[i] = 1.0f / powf(10000.0f, (float)(2 * i) / 64.0f);
#if MK_N_LAUNCHES == 1
    a.ph_lo = 0; a.ph_hi = N_PHASES;
    hipLaunchKernelGGL(fwd, dim3(grid), dim3(NTHR), LDS_BYTES, stream, a);
#else
    for (int p = 0; p < N_PHASES; ++p) { a.ph_lo = p; a.ph_hi = p + 1; hipLaunchKernelGGL(fwd, dim3(grid), dim3(NTHR), LDS_BYTES, stream, a); }
#endif
}
```

```cpp
#include <hip/hip_runtime.h>
#include <cstdio>
#include <cstdint>

#ifndef MK_N_LAUNCHES
#define MK_N_LAUNCHES 1
#endif

#ifndef FP8_MOE
#define FP8_MOE 1
#endif
#ifndef FP8_IN
#define FP8_IN 1
#endif
#ifndef FP8_O
#define FP8_O 1
#endif
#ifndef PROBE_DUP
#define PROBE_DUP -1
#endif

#define LAS __attribute__((address_space(3)))
#define GAS __attribute__((address_space(1)))
typedef unsigned short bf16_t;
typedef short bf16x8 __attribute__((ext_vector_type(8)));
typedef short s16x4 __attribute__((ext_vector_type(4)));
typedef float f32x2 __attribute__((ext_vector_type(2)));
typedef float f32x4 __attribute__((ext_vector_type(4)));
typedef float f32x16 __attribute__((ext_vector_type(16)));
typedef unsigned u32x2 __attribute__((ext_vector_type(2)));
typedef unsigned u32x4 __attribute__((ext_vector_type(4)));
typedef GAS unsigned gu32;
typedef int v8i32 __attribute__((ext_vector_type(8)));
typedef int v4i32 __attribute__((ext_vector_type(4)));

constexpr int BATCH = 2, SEQ = 16384, T = BATCH * SEQ, D = 2048, DEPTH = 2;
constexpr int PW = 9472;
constexpr int XA_OFF = 0, QB_OFF = 512, KB_OFF = 1536, VB_OFF = 1664, QM_OFF = 1792, KM_OFF = 2304, VM_OFF = 2816, G_OFF = 3328;
constexpr int NEXP = 32, FF = 1024, CAP = 65536;
constexpr int NWAVES = 8, NTHR = 512;
constexpr float RMS_EPS = 1e-6f;
constexpr float LOG2E = 1.4426950408889634f;
constexpr float C2 = 0.125f * LOG2E;

constexpr size_t MiB = 1u << 20;
constexpr size_t WS_CTL = 0, CTL_ZERO_BYTES = 1 * MiB;
constexpr size_t WS_ROPE = 2 * MiB;
constexpr size_t WS_KMP = 6 * MiB;
constexpr size_t WS_SEL = 7 * MiB;
constexpr size_t WS_ML = 8 * MiB;
constexpr size_t WS_TOKR = 16 * MiB;
constexpr size_t WS_RS1 = 16 * MiB + 512 * 1024, WS_RS2 = 16 * MiB + 640 * 1024;
constexpr size_t WS_SLOT_TOK = 17 * MiB;
constexpr size_t WS_SLOT_W = 25 * MiB;
constexpr size_t WS_LOGITS = 33 * MiB;
constexpr size_t WS_WIN = 49 * MiB;
constexpr size_t WS_WIN8 = 62 * MiB;
constexpr size_t WS_WUPA = 85 * MiB;
constexpr size_t WS_WO = 93 * MiB;
constexpr size_t WS_WR = 101 * MiB;
constexpr size_t WS_POOLW = 102 * MiB;
constexpr size_t WS_W13 = 104 * MiB;
constexpr size_t WS_WD = 360 * MiB;
constexpr size_t WS_G8A = 232 * MiB, WS_G8B = 296 * MiB, WS_G8C = 424 * MiB;
static_assert(WS_G8B == WS_G8A + 64 * MiB && WS_G8C == WS_G8A + 192 * MiB, "EpiGate8 branch offsets");
constexpr size_t WS_H = 488 * MiB;
constexpr size_t WS_PROJ = 617 * MiB;
constexpr size_t WS_ACT = 617 * MiB;
constexpr size_t WS_Y = 761 * MiB;
constexpr size_t WS_YA = 1209 * MiB;
constexpr size_t WS_MERGED = 1337 * MiB;
constexpr size_t WS_OPART = 1465 * MiB;
constexpr size_t WS_H8 = 1657 * MiB;
constexpr size_t WS_X = 1721 * MiB;
constexpr size_t WS_END = 1849 * MiB;
static_assert(WS_PROJ + (size_t)T * PW * 2 <= WS_YA && WS_Y + (size_t)73728 * 2048 * 2 <= WS_YA && WS_WIN8 + (size_t)6144 * D <= WS_WUPA, "ws map");

constexpr int CW_TMO = 0;
constexpr int CW_BAR = 4096;
constexpr int CW_CNT = 8192;
constexpr int CW_Q = 8448;

constexpr int RING_BYTES = 131072;
constexpr int MISC_OFF = RING_BYTES;
constexpr int LDS_BYTES = 147456;

__device__ __forceinline__ unsigned f2bf(float f) { unsigned u = __builtin_bit_cast(unsigned, f); return (u + 0x7fffu + ((u >> 16) & 1u)) >> 16; }
__device__ __forceinline__ unsigned pk2(float lo, float hi) { return f2bf(lo) | (f2bf(hi) << 16); }
__device__ __forceinline__ float bflo(unsigned w) { return __builtin_bit_cast(float, w << 16); }
__device__ __forceinline__ float bfhi(unsigned w) { return __builtin_bit_cast(float, w & 0xffff0000u); }
typedef __bf16 bf16x2_t __attribute__((ext_vector_type(2)));
__device__ __forceinline__ unsigned cvt_pk_bf16(float lo, float hi) { const f32x2 v = {lo, hi}; const bf16x2_t b = __builtin_convertvector(v, bf16x2_t); return __builtin_bit_cast(unsigned, b); }
constexpr int F8_WSH = 5, F8_HSH = 3, F8_ASH = 2, F8_YSH = 6, F8_GSH = 4, F8_MSH = 4;
__device__ __forceinline__ float clamp448(float v) { return __builtin_fminf(__builtin_fmaxf(v, -448.f), 448.f); }
__device__ __forceinline__ unsigned pk4_fp8(float a, float b, float c, float d) {
    int p = 0; p = __builtin_amdgcn_cvt_pk_fp8_f32(clamp448(a), clamp448(b), p, false); p = __builtin_amdgcn_cvt_pk_fp8_f32(clamp448(c), clamp448(d), p, true); return (unsigned)p; }
#define LDS_WAIT() asm volatile("s_waitcnt lgkmcnt(0)" ::: "memory")
#define VM_WAIT() asm volatile("s_waitcnt vmcnt(0)" ::: "memory")
#define RLX_AGENT __ATOMIC_RELAXED, __HIP_MEMORY_SCOPE_AGENT

namespace pg8 {
constexpr int BM = 256, BK = 64, HALF = 128, HTB = HALF * BK * 2, STAGE_BYTES = 8 * HTB, NXCD = 8, WGM = 8;
__host__ __device__ __forceinline__ int lds_byte(int r, int c) { const int st = (r >> 4) * 2 + (c >> 5), rr = r & 15, cc = c & 31, ob = rr * 64 + cc * 2; return st * 1024 + (ob ^ (((ob >> 9) & 1) << 5)); }
__host__ __device__ __forceinline__ void stage_rc(int b, int& R, int& C) { const int st = b / 1024, sb = b % 1024, swz = sb ^ (((sb >> 9) & 1) << 5); R = (st >> 1) * 16 + swz / 64; C = (st & 1) * 32 + (swz % 64) / 2; }
__host__ __device__ __forceinline__ int perm32(int rho) { const int n = rho >> 4, i = rho & 15; return 8 * (i >> 2) + 4 * n + (i & 3); }

struct Unit { int pm, pn, e, nrow, rank0; };

__device__ __forceinline__ bool static_tile(int nM, int nN, int G, int c, int i, int& pm, int& pn) {
    const int nwg = nM * nN; const long L = (long)i * G + c; if (L >= nwg) return false;
    int wgid = (int)L; { const int q = nwg / NXCD, r = nwg % NXCD, xcd = wgid % NXCD, off = wgid / NXCD; wgid = (xcd < r ? xcd * (q + 1) : r * (q + 1) + (xcd - r) * q) + off; }
    const int nig = WGM * nN, gid = wgid / nig, fm = gid * WGM, gsz = (nM - fm) < WGM ? (nM - fm) : WGM;
    pm = fm + ((wgid % nig) % gsz); pn = (wgid % nig) / gsz; return true;
}
struct UnevenSched {
    static constexpr bool GATHER = false;
    const void* A; const void* Bt; int nM, nN, Kb, G, c;
    __device__ __forceinline__ bool next(int i, Unit& u) const {
        u.e = 0; u.nrow = 256; u.rank0 = 0;
        if (G != 256) return static_tile(nM, nN, G, c, i, u.pm, u.pn);
        int L;
        if (i < 11) L = i * 256 + c; else if (c >= 128 && i < 13) L = 2816 + 2 * (c - 128) + (i - 11); else return false;
        return static_tile(nM, nN, nM * nN, L, 0, u.pm, u.pn);
    }
    __device__ __forceinline__ const char* a_base(const Unit& u) const { return (const char*)A + (size_t)u.pm * 256 * Kb; }
    __device__ __forceinline__ const char* b_base(const Unit& u) const { return (const char*)Bt + (size_t)u.pn * 256 * Kb; }
    __device__ __forceinline__ unsigned gather(const Unit&, int) const { return 0u; }
};
struct SplitKSched {
    static constexpr bool GATHER = false;
    const void* A; const void* Bt; int nM, Kb, G, c;
    __device__ __forceinline__ bool next(int i, Unit& u) const { const int L = i * G + c; if (L >= 2 * nM) return false; u.pm = L >> 1; u.pn = L & 1; u.e = 0; u.nrow = 256; u.rank0 = 0; return true; }
    __device__ __forceinline__ const char* a_base(const Unit& u) const { return (const char*)A + (size_t)u.pm * 256 * Kb + (size_t)u.pn * (Kb / 2); }
    __device__ __forceinline__ const char* b_base(const Unit& u) const { return (const char*)Bt + (size_t)u.pn * (Kb / 2); }
    __device__ __forceinline__ unsigned gather(const Unit&, int) const { return 0u; }
};
struct DenseSched {
    static constexpr bool GATHER = false;
    const void* A; const void* Bt; int nM, nN, Kb, G, c;
    __device__ __forceinline__ bool next(int i, Unit& u) const { u.e = 0; u.nrow = 256; u.rank0 = 0; return static_tile(nM, nN, G, c, i, u.pm, u.pn); }
    __device__ __forceinline__ const char* a_base(const Unit& u) const { return (const char*)A + (size_t)u.pm * 256 * Kb; }
    __device__ __forceinline__ const char* b_base(const Unit& u) const { return (const char*)Bt + (size_t)u.pn * 256 * Kb; }
    __device__ __forceinline__ unsigned gather(const Unit&, int) const { return 0u; }
};

template <class E, class = void> struct HasMid { static constexpr bool v = false; };
template <class E> struct HasMid<E, decltype((void)E::MID)> { static constexpr bool v = E::MID; };
template <class Epi, class Sched, bool ALIGN_EPI = false, bool SP2 = true, bool FP8 = false, int SC_B = 127, int SC_A = 127>
__device__ __forceinline__ void gemm_phase(LAS unsigned char* lds, const int Kb, const Sched& S, const Epi& E, const int nt_override = 0) {
    int tid_ = threadIdx.x; asm volatile("" : "+v"(tid_));
    const int tid = tid_, wid = __builtin_amdgcn_readfirstlane(tid >> 6), lane = tid & 63, wr = wid >> 2, wc = wid & 3, fr = lane & 15, fq = lane >> 4;
    const int nt = nt_override ? nt_override : Kb / 128;
    constexpr bool GATHER = Sched::GATHER;
    int RA[2], CA[2]; unsigned voffB[2];
#pragma unroll
    for (int i = 0; i < 2; ++i) { int R, C; stage_rc(tid * 16 + i * 8192, R, C); RA[i] = R; CA[i] = C; const int Rb = Epi::PERM ? (64 * (R >> 5) + perm32(R & 31)) : R; voffB[i] = (unsigned)(Rb * Kb + C * 2); }
    const size_t kstep = (size_t)(BK * 2);
    const size_t hstepB = (size_t)(Epi::PERM ? 32 : HALF) * Kb;
    const size_t hstepA = GATHER ? (size_t)0 : (size_t)HALF * Kb;
    const unsigned ldsw = (unsigned)wid * 1024u;
    const int aoff = lds_byte(wr * 64 + fr, fq * 8), boff = lds_byte(wc * 32 + fr, fq * 8);
#define PG8_SA(b, h) (((b) * 2 + (h)) * HTB)
#define PG8_SB(b, h) ((4 + (b) * 2 + (h)) * HTB)
#define PG8_STAGE(bufoff, gbase, voff) do { _Pragma("unroll") for (int _i = 0; _i < 2; ++_i) \
        __builtin_amdgcn_global_load_lds((const unsigned*)((const char*)(gbase) + (voff)[_i]), (LAS unsigned*)(lds + (bufoff) + ldsw + _i * 8192), 16, 0, 0); } while (0)
#define PG8_LD8(base) __builtin_shufflevector(*(const LAS v4i32*)(base), *(const LAS v4i32*)((base) + 1024), 0, 1, 2, 3, 4, 5, 6, 7)
#define PG8_LDA(dst, b, h) do { _Pragma("unroll") for (int m = 0; m < 4; ++m) dst[m] = PG8_LD8(lds + PG8_SA(b, h) + aoff + m * 2048); } while (0)
#define PG8_LDB(dst, b, h) do { _Pragma("unroll") for (int n = 0; n < 2; ++n) dst[n] = PG8_LD8(lds + PG8_SB(b, h) + boff + n * 2048); } while (0)
#define PG8_LO(v) __builtin_bit_cast(bf16x8, __builtin_shufflevector(v, v, 0, 1, 2, 3))
#define PG8_HI(v) __builtin_bit_cast(bf16x8, __builtin_shufflevector(v, v, 4, 5, 6, 7))
#define PG8_MMA(ai, bj, At, Bt) do { __builtin_amdgcn_s_setprio(1); _Pragma("unroll") for (int m = 0; m < 4; ++m) _Pragma("unroll") for (int n = 0; n < 2; ++n) { \
        if constexpr (FP8) asm volatile("v_mfma_scale_f32_16x16x128_f8f6f4 %0, %1, %2, %0, %3, %4 op_sel_hi:[0,0,0]" : "+v"(acc[ai][bj][m][n]) : "v"(Bt[n]), "v"(At[m]), "v"(scb), "v"(sca)); \
        else { acc[ai][bj][m][n] = __builtin_amdgcn_mfma_f32_16x16x32_bf16(PG8_LO(Bt[n]), PG8_LO(At[m]), acc[ai][bj][m][n], 0, 0, 0); \
               acc[ai][bj][m][n] = __builtin_amdgcn_mfma_f32_16x16x32_bf16(PG8_HI(Bt[n]), PG8_HI(At[m]), acc[ai][bj][m][n], 0, 0, 0); } } \
        __builtin_amdgcn_s_setprio(0); } while (0)
#define PG8_WAIT_V(n) asm volatile("s_waitcnt vmcnt(" #n ")" ::: "memory")
#define PG8_WAIT_L(n) asm volatile("s_waitcnt lgkmcnt(" #n ")" ::: "memory")
#define PG8_BAR __builtin_amdgcn_s_barrier()
#define PG8_SCHED __builtin_amdgcn_sched_barrier(0)
    Unit cur, nxt; int ui = 0;
    if (!S.next(0, cur)) return;
    f32x4 acc[2][2][4][2];
#pragma unroll
    for (int a = 0; a < 2; ++a)
#pragma unroll
        for (int b = 0; b < 2; ++b)
#pragma unroll
            for (int m = 0; m < 4; ++m)
#pragma unroll
                for (int n = 0; n < 2; ++n) acc[a][b][m][n] = (f32x4){0.f, 0.f, 0.f, 0.f};
    v8i32 At[4], B0[2], B1[2];
    const int scb = SC_B * 0x01010101, sca = SC_A * 0x01010101;
    unsigned voffA0[2], voffA1[2], nvA0[2], nvA1[2];
#pragma unroll
    for (int i = 0; i < 2; ++i) {
        if constexpr (GATHER) { voffA0[i] = S.gather(cur, RA[i]) + (unsigned)CA[i] * 2u; voffA1[i] = S.gather(cur, RA[i] + HALF) + (unsigned)CA[i] * 2u; nvA0[i] = voffA0[i]; nvA1[i] = voffA1[i]; }
        else { voffA0[i] = (unsigned)(RA[i] * Kb + CA[i] * 2); }
    }
#define VA0 voffA0
#define VA1 (GATHER ? voffA1 : voffA0)
    const char* cA = S.a_base(cur); const char* cB = S.b_base(cur);
    if constexpr (SP2) {
        PG8_STAGE(PG8_SB(0, 0), cB, voffB); PG8_STAGE(PG8_SB(0, 1), cB + hstepB, voffB); PG8_STAGE(PG8_SA(0, 0), cA, voffA0); PG8_STAGE(PG8_SA(0, 1), cA + hstepA, VA1);
        if (wr == 1) PG8_BAR;
        PG8_WAIT_V(2); PG8_BAR;
        PG8_STAGE(PG8_SB(1, 0), cB + kstep, voffB); PG8_STAGE(PG8_SA(1, 0), cA + kstep, voffA0); PG8_STAGE(PG8_SB(1, 1), cB + hstepB + kstep, voffB);
        PG8_WAIT_V(6); PG8_BAR;
    } else {
        PG8_STAGE(PG8_SB(0, 0), cB, voffB); PG8_STAGE(PG8_SA(0, 0), cA, voffA0); PG8_STAGE(PG8_SB(0, 1), cB + hstepB, voffB); PG8_STAGE(PG8_SA(0, 1), cA + hstepA, VA1);
        if (wr == 1) PG8_BAR;
        PG8_WAIT_V(4); PG8_BAR;
        PG8_STAGE(PG8_SB(1, 0), cB + kstep, voffB); PG8_STAGE(PG8_SA(1, 0), cA + kstep, voffA0); PG8_STAGE(PG8_SB(1, 1), cB + hstepB + kstep, voffB);
        PG8_WAIT_V(6); PG8_BAR;
    }
    for (;;) {
        const bool has_next = S.next(ui + 1, nxt);
        const char* nA = has_next ? S.a_base(nxt) : cA; const char* nB = has_next ? S.b_base(nxt) : cB;
        if constexpr (GATHER) {
#pragma unroll
            for (int i = 0; i < 2; ++i) {
                if (has_next) { nvA0[i] = S.gather(nxt, RA[i]) + (unsigned)CA[i] * 2u; nvA1[i] = S.gather(nxt, RA[i] + HALF) + (unsigned)CA[i] * 2u; }
                else { nvA0[i] = voffA0[i]; nvA1[i] = voffA1[i]; }
            }
        }
#pragma unroll 1
        for (int t = 0; t < nt; t += 2) {
            if constexpr (HasMid<Epi>::v) { if (t == Epi::MID_T0 || t == Epi::MID_T1) {
                if constexpr (FP8) {
#pragma unroll
                    for (int a = 0; a < 2; ++a)
#pragma unroll
                        for (int b = 0; b < 2; ++b)
                            asm volatile("s_nop 15\n\ts_nop 15" : "+v"(acc[a][b][0][0]), "+v"(acc[a][b][0][1]), "+v"(acc[a][b][1][0]), "+v"(acc[a][b][1][1]), "+v"(acc[a][b][2][0]), "+v"(acc[a][b][2][1]), "+v"(acc[a][b][3][0]), "+v"(acc[a][b][3][1]));
                }
                E.mid(acc, cur, t == Epi::MID_T1 ? 1 : 0, wr, wc, fr, fq);
                if constexpr (FP8) {
#pragma unroll
                    for (int a = 0; a < 2; ++a)
#pragma unroll
                        for (int b = 0; b < 2; ++b)
                            asm volatile("s_nop 7" : "+v"(acc[a][b][0][0]), "+v"(acc[a][b][0][1]), "+v"(acc[a][b][1][0]), "+v"(acc[a][b][1][1]), "+v"(acc[a][b][2][0]), "+v"(acc[a][b][2][1]), "+v"(acc[a][b][3][0]), "+v"(acc[a][b][3][1]));
                } } }
            const bool last = (t == nt - 2);
            const char* a1 = cA + (size_t)(t + 1) * kstep;
            const char* a2 = last ? nA : cA + (size_t)(t + 2) * kstep; const char* b2 = last ? nB : cB + (size_t)(t + 2) * kstep;
            const char* a3 = a2 + kstep; const char* b3 = b2 + kstep;
            unsigned vA0[2], vA1[2];
#pragma unroll
            for (int i = 0; i < 2; ++i) { if constexpr (GATHER) { vA0[i] = last ? nvA0[i] : voffA0[i]; vA1[i] = last ? nvA1[i] : voffA1[i]; } else { vA0[i] = voffA0[i]; vA1[i] = voffA0[i]; } }
            if constexpr (SP2) {
            PG8_LDB(B0, 0, 0); PG8_LDB(B1, 0, 1); PG8_SCHED; PG8_LDA(At, 0, 0); PG8_STAGE(PG8_SA(1, 1), a1 + hstepA, VA1);
            PG8_WAIT_V(8); PG8_WAIT_L(0); PG8_BAR; PG8_MMA(0, 0, At, B0); PG8_MMA(0, 1, At, B1); PG8_BAR; PG8_SCHED;
            PG8_LDA(At, 0, 1); PG8_STAGE(PG8_SB(0, 0), b2, voffB); PG8_STAGE(PG8_SB(0, 1), b2 + hstepB, voffB); PG8_STAGE(PG8_SA(0, 0), a2, vA0);
            PG8_WAIT_V(8); PG8_WAIT_L(0); PG8_BAR; PG8_MMA(1, 0, At, B0); PG8_MMA(1, 1, At, B1); PG8_BAR; PG8_SCHED;
            PG8_LDB(B0, 1, 0); PG8_LDB(B1, 1, 1); PG8_SCHED; PG8_LDA(At, 1, 0); PG8_STAGE(PG8_SA(0, 1), a2 + hstepA, vA1);
            PG8_WAIT_V(8); PG8_WAIT_L(0); PG8_BAR; PG8_MMA(0, 0, At, B0); PG8_MMA(0, 1, At, B1); PG8_BAR; PG8_SCHED;
            PG8_LDA(At, 1, 1); PG8_STAGE(PG8_SB(1, 0), b3, voffB); PG8_STAGE(PG8_SB(1, 1), b3 + hstepB, voffB); PG8_STAGE(PG8_SA(1, 0), a3, vA0);
            PG8_WAIT_V(8); PG8_WAIT_L(0); PG8_BAR; PG8_MMA(1, 0, At, B0); PG8_MMA(1, 1, At, B1); PG8_BAR; PG8_SCHED;
            } else {
            PG8_LDB(B0, 0, 0); PG8_SCHED; PG8_LDA(At, 0, 0); PG8_STAGE(PG8_SA(1, 1), a1 + hstepA, VA1);
            PG8_WAIT_L(8); PG8_BAR; PG8_WAIT_L(0); PG8_MMA(0, 0, At, B0); PG8_BAR; PG8_SCHED;
            PG8_LDB(B1, 0, 1); PG8_STAGE(PG8_SB(0, 0), b2, voffB);
            PG8_BAR; PG8_WAIT_L(0); PG8_MMA(0, 1, At, B1); PG8_BAR;
            PG8_LDA(At, 0, 1); PG8_STAGE(PG8_SA(0, 0), a2, vA0);
            PG8_BAR; PG8_WAIT_L(0); PG8_MMA(1, 0, At, B0); PG8_BAR; PG8_SCHED;
            PG8_STAGE(PG8_SB(0, 1), b2 + hstepB, voffB);
            PG8_WAIT_V(6); PG8_BAR; PG8_MMA(1, 1, At, B1); PG8_BAR;
            PG8_LDB(B0, 1, 0); PG8_SCHED; PG8_LDA(At, 1, 0); PG8_STAGE(PG8_SA(0, 1), a2 + hstepA, vA1);
            PG8_WAIT_L(8); PG8_BAR; PG8_WAIT_L(0); PG8_MMA(0, 0, At, B0); PG8_BAR; PG8_SCHED;
            PG8_LDB(B1, 1, 1); PG8_STAGE(PG8_SB(1, 0), b3, voffB);
            PG8_BAR; PG8_WAIT_L(0); PG8_MMA(0, 1, At, B1); PG8_BAR;
            PG8_LDA(At, 1, 1); PG8_STAGE(PG8_SA(1, 0), a3, vA0);
            PG8_BAR; PG8_WAIT_L(0); PG8_MMA(1, 0, At, B0); PG8_BAR; PG8_SCHED;
            PG8_STAGE(PG8_SB(1, 1), b3 + hstepB, voffB);
            PG8_WAIT_V(6); PG8_BAR; PG8_MMA(1, 1, At, B1); PG8_BAR;
            }
        }
        if constexpr (ALIGN_EPI) { if (wr == 0) PG8_BAR; }
        if constexpr (FP8) {
#pragma unroll
            for (int a = 0; a < 2; ++a)
#pragma unroll
                for (int b = 0; b < 2; ++b)
                    asm volatile("s_nop 15\n\ts_nop 15" : "+v"(acc[a][b][0][0]), "+v"(acc[a][b][0][1]), "+v"(acc[a][b][1][0]), "+v"(acc[a][b][1][1]), "+v"(acc[a][b][2][0]), "+v"(acc[a][b][2][1]), "+v"(acc[a][b][3][0]), "+v"(acc[a][b][3][1]));
        }
        E(acc, cur, wr, wc, fr, fq);
        if (!has_next) break;
#pragma unroll
        for (int a = 0; a < 2; ++a)
#pragma unroll
            for (int b = 0; b < 2; ++b)
#pragma unroll
                for (int m = 0; m < 4; ++m)
#pragma unroll
                    for (int n = 0; n < 2; ++n) acc[a][b][m][n] = (f32x4){0.f, 0.f, 0.f, 0.f};
        cur = nxt; cA = nA; cB = nB; ++ui;
        if constexpr (GATHER) {
#pragma unroll
            for (int i = 0; i < 2; ++i) { voffA0[i] = nvA0[i]; voffA1[i] = nvA1[i]; } }
        if constexpr (ALIGN_EPI) { if (wr == 1) PG8_BAR; }
    }
    PG8_WAIT_V(0);
    if constexpr (!ALIGN_EPI) { if (wr == 0) PG8_BAR; }
    PG8_BAR;
#undef VA0
#undef VA1
#undef PG8_SA
#undef PG8_SB
#undef PG8_STAGE
#undef PG8_LD8
#undef PG8_LO
#undef PG8_HI
#undef PG8_LDA
#undef PG8_LDB
#undef PG8_MMA
#undef PG8_WAIT_V
#undef PG8_WAIT_L
#undef PG8_BAR
#undef PG8_SCHED
}

__device__ __forceinline__ float sigmoidf_fast(float x) { return __builtin_amdgcn_rcpf(1.0f + __builtin_amdgcn_exp2f(-x * LOG2E)); }

template <bool SIG> struct EpiProj {
    static constexpr bool PERM = true;
    bf16_t* O; int pn0; const float* rs;
    __device__ __forceinline__ void operator()(const f32x4 (&acc)[2][2][4][2], const Unit& u, int wr, int wc, int fr_in, int fq_in) const {
        int fr = fr_in, fq = fq_in; asm volatile("" : "+v"(fr), "+v"(fq));
        const int row0 = u.pm * BM + wr * 64 + fr, col0 = (pn0 + u.pn) * BM + wc * 64 + 8 * fq; constexpr bool sig = SIG;
#pragma unroll
        for (int ai = 0; ai < 2; ++ai)
#pragma unroll
            for (int m = 0; m < 4; ++m) { bf16_t* rowp = O + (size_t)(row0 + ai * HALF + m * 16) * PW + col0; const float rr = rs[row0 + ai * HALF + m * 16];
#pragma unroll
                for (int bj = 0; bj < 2; ++bj) { f32x4 v0 = acc[ai][bj][m][0] * rr, v1 = acc[ai][bj][m][1] * rr;
                    if (sig) {
#pragma unroll
                        for (int j = 0; j < 4; ++j) { v0[j] = sigmoidf_fast(v0[j]); v1[j] = sigmoidf_fast(v1[j]); } }
                    u32x4 w; w.x = cvt_pk_bf16(v0[0], v0[1]); w.y = cvt_pk_bf16(v0[2], v0[3]); w.z = cvt_pk_bf16(v1[0], v1[1]); w.w = cvt_pk_bf16(v1[2], v1[3]);
                    *(u32x4*)(rowp + bj * 32) = w; } }
    }
};
struct EpiGate8 {
    static constexpr bool PERM = true;
    unsigned char* g8;
    __device__ __forceinline__ void operator()(const f32x4 (&acc)[2][2][4][2], const Unit& u, int wr, int wc, int fr_in, int fq_in) const {
        int fr = fr_in, fq = fq_in; asm volatile("" : "+v"(fr), "+v"(fq));
        const int row0 = u.pm * BM + wr * 64 + fr, col0 = (u.pn & 7) * BM + wc * 64 + 8 * fq; const int br = u.pn >> 3; unsigned char* base = g8 + ((size_t)(br + (br >> 1)) << 26);
        constexpr float sc = (float)(1 << F8_GSH);
#pragma unroll
        for (int ai = 0; ai < 2; ++ai)
#pragma unroll
            for (int m = 0; m < 4; ++m) { unsigned char* rowp = base + (size_t)(row0 + ai * HALF + m * 16) * D + col0;
#pragma unroll
                for (int bj = 0; bj < 2; ++bj) { const f32x4 v0 = acc[ai][bj][m][0] * sc, v1 = acc[ai][bj][m][1] * sc;
                    u32x2 w; w.x = pk4_fp8(v0[0], v0[1], v0[2], v0[3]); w.y = pk4_fp8(v1[0], v1[1], v1[2], v1[3]);
                    *(u32x2*)(rowp + bj * 32) = w; } }
    }
};
struct EpiUpH {
    static constexpr bool PERM = true, MID = true; static constexpr int MID_T0 = 4, MID_T1 = 12;
    const unsigned char* G; unsigned char* M8;
    __device__ __forceinline__ void mid(f32x4 (&acc)[2][2][4][2], const Unit& u, int which, int wr, int wc, int fr_in, int fq_in) const {
        int fr = fr_in, fq = fq_in; asm volatile("" : "+v"(fr), "+v"(fq));
        const int row0 = u.pm * BM + wr * 64 + fr, col0 = u.pn * BM + wc * 64 + 8 * fq;
        const unsigned char* G1 = G + (which ? ((size_t)1 << 26) : (size_t)0); const unsigned char* G2 = G + (which ? ((size_t)3 << 26) : ((size_t)1 << 26));
        constexpr float gs = -LOG2E / (float)(1 << F8_GSH);
#pragma unroll
        for (int ai = 0; ai < 2; ++ai) {
            u32x2 g1[4][2], g2[4][2];
#pragma unroll
            for (int m = 0; m < 4; ++m)
#pragma unroll
                for (int bj = 0; bj < 2; ++bj) { const size_t off = (size_t)(row0 + ai * HALF + m * 16) * D + col0 + bj * 32;
                    g1[m][bj] = *(const u32x2*)(G1 + off); g2[m][bj] = *(const u32x2*)(G2 + off); }
            asm volatile("" ::: "memory");
#pragma unroll
            for (int m = 0; m < 4; ++m)
#pragma unroll
                for (int bj = 0; bj < 2; ++bj) { const u32x2 a = g1[m][bj], b = g2[m][bj];
#define RT(w1, w2, k) ((1.0f + __builtin_amdgcn_exp2f(__builtin_amdgcn_cvt_f32_fp8((int)(w2), k) * gs)) * __builtin_amdgcn_rcpf(1.0f + __builtin_amdgcn_exp2f(__builtin_amdgcn_cvt_f32_fp8((int)(w1), k) * gs)))
                    acc[ai][bj][m][0][0] *= RT(a.x, b.x, 0); acc[ai][bj][m][0][1] *= RT(a.x, b.x, 1); acc[ai][bj][m][0][2] *= RT(a.x, b.x, 2); acc[ai][bj][m][0][3] *= RT(a.x, b.x, 3);
                    acc[ai][bj][m][1][0] *= RT(a.y, b.y, 0); acc[ai][bj][m][1][1] *= RT(a.y, b.y, 1); acc[ai][bj][m][1][2] *= RT(a.y, b.y, 2); acc[ai][bj][m][1][3] *= RT(a.y, b.y, 3);
#undef RT
                }
            asm volatile("" ::: "memory");
        }
    }
    __device__ __forceinline__ void operator()(const f32x4 (&acc)[2][2][4][2], const Unit& u, int wr, int wc, int fr_in, int fq_in) const {
        int fr = fr_in, fq = fq_in; asm volatile("" : "+v"(fr), "+v"(fq));
        const int row0 = u.pm * BM + wr * 64 + fr, col0 = u.pn * BM + wc * 64 + 8 * fq;
        const unsigned char* G3 = G + ((size_t)3 << 26);
        constexpr float gs = -LOG2E / (float)(1 << F8_GSH), sc = (float)(1 << F8_HSH);
#pragma unroll
        for (int ai = 0; ai < 2; ++ai) {
            u32x2 g[4][2];
#pragma unroll
            for (int m = 0; m < 4; ++m)
#pragma unroll
                for (int bj = 0; bj < 2; ++bj) g[m][bj] = *(const u32x2*)(G3 + (size_t)(row0 + ai * HALF + m * 16) * D + col0 + bj * 32);
            asm volatile("" ::: "memory");
#pragma unroll
            for (int m = 0; m < 4; ++m)
#pragma unroll
                for (int bj = 0; bj < 2; ++bj) { const u32x2 gg = g[m][bj]; const f32x4 v0 = acc[ai][bj][m][0], v1 = acc[ai][bj][m][1];
#define SG(w, k) (sc * __builtin_amdgcn_rcpf(1.0f + __builtin_amdgcn_exp2f(__builtin_amdgcn_cvt_f32_fp8((int)(w), k) * gs)))
                    u32x2 w; w.x = pk4_fp8(v0[0] * SG(gg.x, 0), v0[1] * SG(gg.x, 1), v0[2] * SG(gg.x, 2), v0[3] * SG(gg.x, 3));
                    w.y = pk4_fp8(v1[0] * SG(gg.y, 0), v1[1] * SG(gg.y, 1), v1[2] * SG(gg.y, 2), v1[3] * SG(gg.y, 3));
#undef SG
                    *(u32x2*)(M8 + (size_t)(row0 + ai * HALF + m * 16) * D + col0 + bj * 32) = w; }
            asm volatile("" ::: "memory");
        }
    }
};
template <bool BASE_F32> struct EpiResid {
    static constexpr bool PERM = true; static constexpr int NSTORE = 16;
    const float* basef; bf16_t* X;
    __device__ __forceinline__ void operator()(const f32x4 (&acc)[2][2][4][2], const Unit& u, int wr, int wc, int fr_in, int fq_in) const {
        int fr = fr_in, fq = fq_in; asm volatile("" : "+v"(fr), "+v"(fq));
        const int row0 = u.pm * BM + wr * 64 + fr, col0 = u.pn * BM + wc * 64 + 8 * fq;
#pragma unroll
        for (int ai = 0; ai < 2; ++ai) {
            f32x4 b0[4][2], b1[4][2];
#pragma unroll
            for (int m = 0; m < 4; ++m)
#pragma unroll
                for (int bj = 0; bj < 2; ++bj) { const size_t off = (size_t)(row0 + ai * HALF + m * 16) * D + col0 + bj * 32;
                    if constexpr (BASE_F32) { b0[m][bj] = *(const f32x4*)(basef + off); b1[m][bj] = *(const f32x4*)(basef + off + 4); }
                    else { const u32x4 r = *(const u32x4*)(X + off); b0[m][bj] = (f32x4){bflo(r.x), bfhi(r.x), bflo(r.y), bfhi(r.y)}; b1[m][bj] = (f32x4){bflo(r.z), bfhi(r.z), bflo(r.w), bfhi(r.w)}; } }
            asm volatile("" ::: "memory");
#pragma unroll
            for (int m = 0; m < 4; ++m)
#pragma unroll
                for (int bj = 0; bj < 2; ++bj) { const size_t off = (size_t)(row0 + ai * HALF + m * 16) * D + col0 + bj * 32;
                    const f32x4 v0 = b0[m][bj] + acc[ai][bj][m][0], v1 = b1[m][bj] + acc[ai][bj][m][1];
                    u32x4 w; w.x = cvt_pk_bf16(v0[0], v0[1]); w.y = cvt_pk_bf16(v0[2], v0[3]); w.z = cvt_pk_bf16(v1[0], v1[1]); w.w = cvt_pk_bf16(v1[2], v1[3]);
                    *(u32x4*)(X + off) = w; }
            asm volatile("" ::: "memory");
        }
    }
};
struct EpiLogits {
    static constexpr bool PERM = false;
    float* L; const float* rs; float scale;
    __device__ __forceinline__ void operator()(const f32x4 (&acc)[2][2][4][2], const Unit& u, int wr, int wc, int fr_in, int fq_in) const {
        int fr = fr_in, fq = fq_in; asm volatile("" : "+v"(fr), "+v"(fq));
        if (wc >= 2) return;
        const int row0 = u.pm * BM + wr * 64 + fr, col0 = wc * 32 + 4 * fq; float* Lk = L + (size_t)u.pn * ((size_t)T * 64);
#pragma unroll
        for (int ai = 0; ai < 2; ++ai)
#pragma unroll
            for (int m = 0; m < 4; ++m) { float* rp = Lk + (size_t)(row0 + ai * HALF + m * 16) * 64 + col0; const float rr = rs[row0 + ai * HALF + m * 16];
#pragma unroll
                for (int n = 0; n < 2; ++n) *(f32x4*)(rp + n * 16) = acc[ai][0][m][n] * rr; }
    }
};
template <bool F8> struct EpiAct {
    static constexpr bool PERM = true;
    unsigned char* A;
    __device__ __forceinline__ void operator()(const f32x4 (&acc)[2][2][4][2], const Unit& u, int wr, int wc, int fr_in, int fq_in) const {
        int fr = fr_in, fq = fq_in; asm volatile("" : "+v"(fr), "+v"(fq));
        const int row0 = u.pm * BM + wr * 64 + fr, col0 = u.pn * HALF + wc * 32 + 8 * fq;
#pragma unroll
        for (int ai = 0; ai < 2; ++ai)
#pragma unroll
            for (int m = 0; m < 4; ++m) { float v[8];
#pragma unroll
                for (int n = 0; n < 2; ++n)
#pragma unroll
                    for (int j = 0; j < 4; ++j) { const float g = acc[ai][0][m][n][j], up = acc[ai][1][m][n][j]; v[4 * n + j] = g * sigmoidf_fast(g) * up; }
                if constexpr (F8) { constexpr float sc = (float)(1 << F8_ASH);
                    u32x2 w; w.x = pk4_fp8(v[0] * sc, v[1] * sc, v[2] * sc, v[3] * sc); w.y = pk4_fp8(v[4] * sc, v[5] * sc, v[6] * sc, v[7] * sc);
                    *(u32x2*)(A + (size_t)(row0 + ai * HALF + m * 16) * FF + col0) = w; }
                else { u32x4 w; w.x = cvt_pk_bf16(v[0], v[1]); w.y = cvt_pk_bf16(v[2], v[3]); w.z = cvt_pk_bf16(v[4], v[5]); w.w = cvt_pk_bf16(v[6], v[7]);
                    *(u32x4*)((bf16_t*)A + (size_t)(row0 + ai * HALF + m * 16) * FF + col0) = w; } }
    }
};
struct EpiDown {
    static constexpr bool PERM = true;
    unsigned char* Y; const float* slot_w;
    __device__ __forceinline__ void operator()(const f32x4 (&acc)[2][2][4][2], const Unit& u, int wr, int wc, int fr_in, int fq_in) const {
        int fr = fr_in, fq = fq_in; asm volatile("" : "+v"(fr), "+v"(fq));
        const int rl0 = wr * 64 + fr, col0 = u.pn * BM + wc * 64 + 8 * fq;
#pragma unroll
        for (int ai = 0; ai < 2; ++ai)
#pragma unroll
            for (int m = 0; m < 4; ++m) { const int rl = rl0 + ai * HALF + m * 16; const float w8 = (rl < u.nrow) ? slot_w[(size_t)u.e * CAP + (size_t)u.rank0 + rl] * (float)(1 << F8_YSH) : 0.f;
                unsigned char* rowp = Y + (size_t)(u.pm * BM + rl) * D + col0;
#pragma unroll
                for (int bj = 0; bj < 2; ++bj) { const f32x4 v0 = acc[ai][bj][m][0] * w8, v1 = acc[ai][bj][m][1] * w8;
                    u32x2 w; w.x = pk4_fp8(v0[0], v0[1], v0[2], v0[3]); w.y = pk4_fp8(v1[0], v1[1], v1[2], v1[3]);
                    *(u32x2*)(rowp + bj * 32) = w; } }
    }
};
}

#define XB_TMO      128
#define XB_XCNT(j)  (256  + 64 * (j))
#define XB_XSUB(j)  (1280 + 64 * (j))
#define XB_XGEN(j)  (2304 + 64 * (j))
#define XB_TOP      3328
#define XB_TOPGEN   3392
#define XCD_BAR_WORDS 3456
#define XB_SPIN_CAP (1u << 18)
__device__ __forceinline__ unsigned xb_ld(unsigned* p)              { return __hip_atomic_load(p, __ATOMIC_RELAXED, __HIP_MEMORY_SCOPE_AGENT); }
__device__ __forceinline__ unsigned xb_add(unsigned* p, unsigned v) { return __hip_atomic_fetch_add(p, v, __ATOMIC_RELAXED, __HIP_MEMORY_SCOPE_AGENT); }
__device__ __forceinline__ unsigned xb_xcc_id() { return (unsigned)__builtin_amdgcn_s_getreg((3 << 11) | 20) & 0xFu; }
#define XB_SPIN(cond, bar) do { unsigned _sp = 0; while (cond) { __builtin_amdgcn_s_sleep(1); \
    if ((++_sp & 255u) == 0u) { if (xb_ld(&(bar)[XB_TMO])) break; if (_sp > XB_SPIN_CAP) { atomicAdd(&(bar)[XB_TMO], 1u); break; } } } } while (0)
struct XcdBarrier { unsigned* bar; unsigned x; volatile LAS unsigned* st; };
__device__ __forceinline__ XcdBarrier xcd_barrier_post(unsigned* bar, volatile LAS unsigned* st) {
    XcdBarrier b; b.bar = bar; b.x = xb_xcc_id(); b.st = st;
    if (threadIdx.x == 0) (void)xb_add(&bar[XB_XCNT(b.x)], 1u);
    return b;
}
__device__ __forceinline__ void xcd_barrier_complete(unsigned* bar, unsigned x, unsigned& nloc, unsigned& nx) {
    const unsigned G = gridDim.x * gridDim.y * gridDim.z;
    unsigned sum, cnt, mine, sp = 0u;
    for (;;) {
        sum = 0u; cnt = 0u; mine = 0u;
#pragma unroll
        for (unsigned j = 0; j < 16; ++j) { const unsigned c = xb_ld(&bar[XB_XCNT(j)]); sum += c; cnt += (c > 0u) ? 1u : 0u; mine = (j == x) ? c : mine; }
        if (sum == G) break;
        __builtin_amdgcn_s_sleep(1);
        if ((++sp & 255u) == 0u) { if (xb_ld(&bar[XB_TMO])) break; if (sp > XB_SPIN_CAP) { atomicAdd(&bar[XB_TMO], 1u); break; } }
    }
    nloc = mine > 0u ? mine : 1u; nx = cnt > 0u ? cnt : 1u;
}
__device__ __forceinline__ void xcd_barrier(const XcdBarrier& b) {
    asm volatile("s_waitcnt vmcnt(0)" ::: "memory");
    __syncthreads();
    if (threadIdx.x == 0) {
        unsigned* bar = b.bar;
        __builtin_amdgcn_s_waitcnt(0);
        unsigned nloc = b.st[0], nx = b.st[1];
        if (nloc == 0u) { xcd_barrier_complete(bar, b.x, nloc, nx); b.st[0] = nloc; b.st[1] = nx; }
        const unsigned old = xb_add(&bar[XB_XSUB(b.x)], 1u);
        const unsigned gen = old / nloc;
        if (old + 1u == (gen + 1u) * nloc) {
            __builtin_amdgcn_fence(__ATOMIC_RELEASE, "agent");
            asm volatile("s_waitcnt vmcnt(0)" ::: "memory");
            const unsigned og = xb_add(&bar[XB_TOP], 1u);
            const unsigned tg = og / nx;
            if (og + 1u == (tg + 1u) * nx) xb_add(&bar[XB_TOPGEN], 1u);
            else XB_SPIN(xb_ld(&bar[XB_TOPGEN]) == tg, bar);
            __builtin_amdgcn_fence(__ATOMIC_ACQUIRE, "agent");
            xb_add(&bar[XB_XGEN(b.x)], 1u);
            asm volatile("s_waitcnt vmcnt(0)" ::: "memory");
        } else {
            XB_SPIN(xb_ld(&bar[XB_XGEN(b.x)]) == gen, bar);
            __builtin_amdgcn_fence(__ATOMIC_ACQUIRE, "agent");
            asm volatile("s_waitcnt vmcnt(0)" ::: "memory");
        }
    }
    __syncthreads();
}

struct Args { const float* in[20]; float* out; unsigned char* ws; float inv_freq[32]; int ph_lo, ph_hi; };
enum { I_X = 0, I_NORM_MIX, I_W_IN, I_POOL_W, I_POOL_SCALE, I_SWA_QN, I_SWA_KN, I_SWA_SINKS, I_MOBA_QN, I_MOBA_KN, I_W_UP_A, I_W_UP_B, I_W_UP_C, I_W_O, I_NORM_FFN,
       I_W_RG, I_W_RE, I_W_EG, I_W_EU, I_W_ED };

typedef const __attribute__((address_space(4))) Args* ArgsP;
struct Frame {
    LAS unsigned char* lds;
    gu32* ctl;
    unsigned char* ws;
    ArgsP ap;
    int tid, lane, wave, G, bid;
};
__device__ __forceinline__ float wave_sum(float v) {
#pragma unroll
    for (int o = 1; o < 64; o <<= 1) v += __shfl_xor(v, o);
    return v;
}

__device__ __forceinline__ void transpose_item(const float* W, int K, int N, bf16_t* WT, int kb, int nb, int rowbase, LAS float* scr, int lane, const float* kgain = nullptr, int dpitch = 0) {
    const int DP = dpitch ? dpitch : K;
    const int k0 = 64 * kb, n0 = 32 * nb;
#pragma unroll 8
    for (int i = 0; i < 32; ++i) { const int kk = 2 * i + (lane >> 5); const float gk = kgain ? kgain[k0 + kk] : 1.0f; scr[kk * 33 + (lane & 31)] = W[(size_t)(k0 + kk) * N + n0 + (lane & 31)] * gk; }
    LDS_WAIT(); asm volatile("" ::: "memory");
    const int c = lane & 7;
#pragma unroll
    for (int j = 0; j < 4; ++j) { const int n = (lane >> 3) + 8 * j; const LAS float* s = scr + (8 * c) * 33 + n;
        u32x4 o; o.x = pk2(s[0 * 33], s[1 * 33]); o.y = pk2(s[2 * 33], s[3 * 33]); o.z = pk2(s[4 * 33], s[5 * 33]); o.w = pk2(s[6 * 33], s[7 * 33]);
        *(GAS u32x4*)(WT + (size_t)(rowbase + n) * DP + k0 + 8 * c) = o; }
    LDS_WAIT(); asm volatile("" ::: "memory");
}
template <bool ILV>
__device__ __forceinline__ void transpose_item_fp8(const float* W, int K, int N, unsigned char* WT, int kb, int nb, int rowbase, LAS unsigned char* scr, int lane, int dpitch = 0) {
    const int DP = dpitch ? dpitch : K;
    const int k0 = 128 * kb, n0 = 64 * nb; constexpr float sc = (float)(1 << F8_WSH);
    const float* wp = W + (size_t)k0 * N + n0 + lane;
    float va[32], vb[32];
#define TLD(dst, b) do { _Pragma("unroll") for (int j = 0; j < 32; ++j) dst[j] = wp[(size_t)(32 * (b) + j) * N]; asm volatile("" ::: "memory"); } while (0)
#define TST(src, b) do { _Pragma("unroll") for (int j = 0; j < 8; ++j) *(LAS unsigned*)(scr + lane * 132 + 4 * (8 * (b) + j)) = pk4_fp8(src[4 * j] * sc, src[4 * j + 1] * sc, src[4 * j + 2] * sc, src[4 * j + 3] * sc); asm volatile("" ::: "memory"); } while (0)
    TLD(va, 0); TLD(vb, 1); TST(va, 0); TLD(va, 2); TST(vb, 1); TLD(vb, 3); TST(va, 2); TST(vb, 3);
#undef TLD
#undef TST
    LDS_WAIT(); asm volatile("" ::: "memory");
    const int c = lane & 7;
#pragma unroll
    for (int j = 0; j < 8; ++j) { const int nn = (lane >> 3) + 8 * j; const LAS unsigned* sp = (const LAS unsigned*)(scr + nn * 132 + 16 * c);
        u32x4 o; o.x = sp[0]; o.y = sp[1]; o.z = sp[2]; o.w = sp[3];
        const int row = rowbase + (ILV ? 64 * (nn >> 5) + (nn & 31) : nn);
        *(GAS u32x4*)(WT + (size_t)row * DP + k0 + 16 * c) = o; }
    LDS_WAIT(); asm volatile("" ::: "memory");
}
__device__ __forceinline__ void conv_phase(const Frame& F, int l) {
    const ArgsP a_ = F.ap;
#define a (*a_)
    LAS float* scr = (LAS float*)(F.lds + F.wave * 16384);
    unsigned char* ws = F.ws;
    const int gw = F.bid * NWAVES + F.wave, NGW = F.G * NWAVES;
    LAS unsigned char* scr8 = F.lds + F.wave * 16384;
    constexpr int I_INB = 32 * 104, I_IN8 = 16 * 96, I_UA = 4 * 32, I_UB = 8 * 32, I_UC = 4 * 32, I_O = 16 * 32, I_EG = 32 * 256, I_EU = 32 * 256, I_ED = 32 * 256;
    constexpr int NITEMS = I_INB + I_IN8 + I_UA + I_UB + I_UC + I_O + I_EG + I_EU + I_ED;
    static_assert(FP8_IN == 1 && FP8_MOE == 1 && FP8_O == 1, "conv_phase item lists are written for the fp8 build");
    for (int it = gw; it < NITEMS; it += NGW) {
        int r = it;
        if (r < I_EG + I_EU) {
            const int isup = r >= I_EG; if (isup) r -= I_EG;
            const int e = r >> 8, q = r & 255, kb = q >> 4, nb = q & 15, n0 = 64 * nb;
            const float* src = a.in[isup ? I_W_EU : I_W_EG] + ((size_t)l * NEXP + e) * (size_t)D * FF;
            transpose_item_fp8<true>(src, D, FF, ws + WS_W13 + (size_t)e * 2048 * D, kb, nb, 256 * (n0 >> 7) + 64 * ((n0 & 127) >> 5) + 32 * isup, scr8, F.lane); continue; }
        r -= I_EG + I_EU;
        if (r < I_ED) { const int e = r >> 8, q = r & 255, kb = q >> 5, nb = q & 31;
            transpose_item_fp8<false>(a.in[I_W_ED] + ((size_t)l * NEXP + e) * (size_t)FF * D, FF, D, ws + WS_WD + (size_t)e * 2048 * FF, kb, nb, 64 * nb, scr8, F.lane); continue; }
        r -= I_ED;
        if (r < I_IN8) { const int kb = r / 96, nb = r % 96;
            transpose_item_fp8<false>(a.in[I_W_IN] + (size_t)l * D * PW, D, PW, ws + WS_WIN8, kb, nb + 52, 64 * nb, scr8, F.lane); continue; }
        r -= I_IN8;
        if (r < I_INB) { const int kb = r / 104, nb = r % 104;
            transpose_item(a.in[I_W_IN] + (size_t)l * D * PW, D, PW, (bf16_t*)(ws + WS_WIN), kb, nb, 32 * nb, scr, F.lane, a.in[I_NORM_MIX] + (size_t)l * D); continue; }
        r -= I_INB;
        if (r < I_UA) { transpose_item_fp8<false>(a.in[I_W_UP_A] + (size_t)l * 512 * D, 512, D, ws + WS_WUPA, r / 32, r % 32, 64 * (r % 32), scr8, F.lane, D); continue; } r -= I_UA;
        if (r < I_UB) { transpose_item_fp8<false>(a.in[I_W_UP_B] + (size_t)l * 1024 * D, 1024, D, ws + WS_WUPA + 512, r / 32, r % 32, 64 * (r % 32), scr8, F.lane, D); continue; } r -= I_UB;
        if (r < I_UC) { transpose_item_fp8<false>(a.in[I_W_UP_C] + (size_t)l * 512 * D, 512, D, ws + WS_WUPA + 1536, r / 32, r % 32, 64 * (r % 32), scr8, F.lane, D); continue; } r -= I_UC;
        transpose_item_fp8<false>(a.in[I_W_O] + (size_t)l * D * D, D, D, ws + WS_WO, r / 32, r % 32, 64 * (r % 32), scr8, F.lane);
    }
    const int gt = F.bid * NTHR + F.tid, NGT = F.G * NTHR;
    { bf16_t* wr = (bf16_t*)(ws + WS_WR); const float* wg = a.in[I_W_RG] + (size_t)l * D * 4; const float* we = a.in[I_W_RE] + (size_t)l * D * 32;
      const float* gf = a.in[I_NORM_FFN] + (size_t)l * D;
      for (int i = gt; i < 256 * D; i += NGT) { const int n = i >> 11, k = i & 2047; const float v = n < 4 ? wg[k * 4 + n] : (n < 36 ? we[k * 32 + (n - 4)] : 0.f); wr[i] = (bf16_t)f2bf(v * gf[k]); } }
    { bf16_t* pw = (bf16_t*)(ws + WS_POOLW); const float* src = a.in[I_POOL_W] + (size_t)l * 4 * 128 * 128;
      for (int i = gt; i < 4 * 128 * 128; i += NGT) { const int g = i >> 14, e = (i >> 7) & 127, c = i & 127; pw[i] = (bf16_t)f2bf(src[(g * 128 + c) * 128 + e]); } }
    if (l == 0) {
        f32x2* rt = (f32x2*)(ws + WS_ROPE);
        for (int i = gt; i < SEQ * 32; i += NGT) {
            const int pos = i >> 5, fi = i & 31; const float ang = (float)pos * a.inv_freq[fi];
            const double x = (double)ang; const double kq = __builtin_rint(x * 0.63661977236758134308);
            double r = __builtin_fma(-kq, 1.57079632679489655800e+00, x); r = __builtin_fma(-kq, 6.12323399573676603587e-17, r);
            const double r2 = r * r;
            double s = -1.0 / 1307674368000.0; s = s * r2 + 1.0 / 6227020800.0; s = s * r2 - 1.0 / 39916800.0; s = s * r2 + 1.0 / 362880.0; s = s * r2 - 1.0 / 5040.0; s = s * r2 + 1.0 / 120.0; s = s * r2 - 1.0 / 6.0; s = s * r2 * r + r;
            double c = 1.0 / 20922789888000.0; c = c * r2 - 1.0 / 87178291200.0; c = c * r2 + 1.0 / 479001600.0; c = c * r2 - 1.0 / 3628800.0; c = c * r2 + 1.0 / 40320.0; c = c * r2 - 1.0 / 720.0; c = c * r2 + 1.0 / 24.0; c = c * r2 - 0.5; c = c * r2 + 1.0;
            const int qd = (int)((long long)kq & 3);
            const double sn = (qd == 0) ? s : (qd == 1) ? c : (qd == 2) ? -s : -c;
            const double cs = (qd == 0) ? c : (qd == 1) ? -s : (qd == 2) ? -c : s;
            rt[i] = (f32x2){(float)cs, (float)sn};
        }
    }
#undef a
}

__device__ __forceinline__ void build_blkbase(const Frame& F, const gu32* cnt) {
    LAS int* bb = (LAS int*)(F.lds + MISC_OFF + 256);
    __syncthreads();
    if (F.tid < 33) { int s = 0; for (int e = 0; e < F.tid; ++e) s += (int)((__hip_atomic_load(cnt + e, RLX_AGENT) + 255u) >> 8); bb[F.tid] = s; }
    __syncthreads();
}
template <int MODE>
__device__ __forceinline__ void norm_phase(const Frame& F, const float* src, float* out, const float* gain, const gu32* cnt_prev) {
    const int gw = F.bid * NWAVES + F.wave, NGW = F.G * NWAVES;
    const LAS int* bb = (const LAS int*)(F.lds + MISC_OFF + 256);
    if (MODE >= 2) build_blkbase(F, cnt_prev);
    unsigned char* H8 = F.ws + WS_H8; float* RS = (float*)(F.ws + (MODE == 1 ? WS_RS2 : WS_RS1));
    bf16_t* X = (bf16_t*)(F.ws + WS_X);
    const unsigned char* Y = F.ws + WS_Y;
    const int* tokr = (const int*)(F.ws + WS_TOKR);
    f32x4 g[8];
    if (MODE != 3) {
#pragma unroll
        for (int j = 0; j < 8; ++j) g[j] = *(const f32x4*)(gain + 4 * F.lane + 256 * j);
    }
    for (int m = gw; m < T; m += NGW) {
        f32x4 v[8];
        if (MODE == 0) { const float* xr = src + (size_t)m * D + 4 * F.lane; bf16_t* xw = X + (size_t)m * D + 4 * F.lane;
#pragma unroll
            for (int j = 0; j < 8; ++j) { const f32x4 t4 = *(const f32x4*)(xr + 256 * j); u32x2 w; w.x = cvt_pk_bf16(t4[0], t4[1]); w.y = cvt_pk_bf16(t4[2], t4[3]); *(u32x2*)(xw + 256 * j) = w;
                v[j] = (f32x4){bflo(w.x), bfhi(w.x), bflo(w.y), bfhi(w.y)}; } }
        else { const bf16_t* xr = X + (size_t)m * D + 4 * F.lane;
#pragma unroll
            for (int j = 0; j < 8; ++j) { const u32x2 r = *(const u32x2*)(xr + 256 * j); v[j] = (f32x4){bflo(r.x), bfhi(r.x), bflo(r.y), bfhi(r.y)}; } }
        if (MODE >= 2) {
            const int e0 = tokr[m * 4 + 0], r0 = tokr[m * 4 + 1], e1 = tokr[m * 4 + 2], r1 = tokr[m * 4 + 3];
            const unsigned char* y0 = Y + ((size_t)bb[e0] * 256 + r0) * D + 4 * F.lane; const unsigned char* y1 = Y + ((size_t)bb[e1] * 256 + r1) * D + 4 * F.lane;
            constexpr float ysc = 1.0f / (float)(1 << F8_YSH);
#pragma unroll
            for (int j = 0; j < 8; ++j) { const int a = *(const int*)(y0 + 256 * j), b = *(const int*)(y1 + 256 * j);
                v[j][0] += (__builtin_amdgcn_cvt_f32_fp8(a, 0) + __builtin_amdgcn_cvt_f32_fp8(b, 0)) * ysc; v[j][1] += (__builtin_amdgcn_cvt_f32_fp8(a, 1) + __builtin_amdgcn_cvt_f32_fp8(b, 1)) * ysc;
                v[j][2] += (__builtin_amdgcn_cvt_f32_fp8(a, 2) + __builtin_amdgcn_cvt_f32_fp8(b, 2)) * ysc; v[j][3] += (__builtin_amdgcn_cvt_f32_fp8(a, 3) + __builtin_amdgcn_cvt_f32_fp8(b, 3)) * ysc; }
            if (MODE == 3) { float* orow = out + (size_t)m * D + 4 * F.lane;
#pragma unroll
                for (int j = 0; j < 8; ++j) *(f32x4*)(orow + 256 * j) = v[j]; }
            else { bf16_t* xw = X + (size_t)m * D + 4 * F.lane;
#pragma unroll
                for (int j = 0; j < 8; ++j) { u32x2 w; w.x = cvt_pk_bf16(v[j][0], v[j][1]); w.y = cvt_pk_bf16(v[j][2], v[j][3]); *(u32x2*)(xw + 256 * j) = w;
                    v[j] = (f32x4){bflo(w.x), bfhi(w.x), bflo(w.y), bfhi(w.y)}; } }
        }
        if (MODE != 3) {
            float s = 0.f;
#pragma unroll
            for (int j = 0; j < 8; ++j) s += (v[j][0] * v[j][0] + v[j][1] * v[j][1]) + (v[j][2] * v[j][2] + v[j][3] * v[j][3]);
            const float rstd = 1.0f / sqrtf(wave_sum(s) * (1.0f / D) + RMS_EPS);
            if (F.lane == 0) RS[m] = rstd;
#pragma unroll
            for (int j = 0; j < 8; ++j) { const float h0 = v[j][0] * rstd * g[j][0], h1 = v[j][1] * rstd * g[j][1], h2 = v[j][2] * rstd * g[j][2], h3 = v[j][3] * rstd * g[j][3];
                constexpr float sc = (float)(1 << F8_HSH);
                *(unsigned*)(H8 + (size_t)m * D + 4 * F.lane + 256 * j) = pk4_fp8(h0 * sc, h1 * sc, h2 * sc, h3 * sc); }
        }
    }
}

__device__ __forceinline__ void qk_norm_rope8(bf16_t* p, const u32x4 raw, const float (&g8)[8], const f32x4 (&cs)[4], int s, float (&y)[8]) {
    float v[8] = {bflo(raw.x), bfhi(raw.x), bflo(raw.y), bfhi(raw.y), bflo(raw.z), bfhi(raw.z), bflo(raw.w), bfhi(raw.w)};
    float ss = 0.f;
#pragma unroll
    for (int i = 0; i < 8; ++i) ss += v[i] * v[i];
    ss += __shfl_xor(ss, 1); ss += __shfl_xor(ss, 2); ss += __shfl_xor(ss, 4);
    const float rstd = 1.0f / sqrtf(ss * (1.0f / 64.0f) + RMS_EPS);
    const float sgn = (s < 4) ? -1.f : 1.f;
#pragma unroll
    for (int i = 0; i < 8; ++i) v[i] = v[i] * rstd * g8[i];
#pragma unroll
    for (int i2 = 0; i2 < 4; ++i2) {
        const float p0 = __shfl_xor(v[2 * i2], 4), p1 = __shfl_xor(v[2 * i2 + 1], 4);
        y[2 * i2] = v[2 * i2] * cs[i2][0] + sgn * p0 * cs[i2][1]; y[2 * i2 + 1] = v[2 * i2 + 1] * cs[i2][2] + sgn * p1 * cs[i2][3]; }
    u32x4 o; o.x = pk2(y[0], y[1]); o.y = pk2(y[2], y[3]); o.z = pk2(y[4], y[5]); o.w = pk2(y[6], y[7]);
    *(u32x4*)p = o;
}
__device__ __forceinline__ void prep_phase(const Frame& F, int l) {
    const ArgsP a_ = F.ap;
#define a (*a_)
    bf16_t* PROJ = (bf16_t*)(F.ws + WS_PROJ);
    const f32x2* rope = (const f32x2*)(F.ws + WS_ROPE);
    float* KMP = (float*)(F.ws + WS_KMP);
    unsigned char* YA = F.ws + WS_YA;
    const bf16_t* POOLW = (const bf16_t*)(F.ws + WS_POOLW);
    const float* pscale = a.in[I_POOL_SCALE] + (size_t)l * 512;
    LAS bf16_t* PT = (LAS bf16_t*)F.lds;
    const int grp = F.tid >> 3, s = F.tid & 7;
    for (int unit = F.bid; unit < T / 128; unit += F.G) {
        const int b = unit >> 7, t0 = (unit & 127) * 128; const size_t tb = (size_t)b * SEQ + t0;
        {
            f32x4 cs[2][4];
#pragma unroll
            for (int it = 0; it < 2; ++it) { const f32x4* rr = (const f32x4*)(rope + (size_t)(t0 + grp + 64 * it) * 32 + 8 * (s & 3));
#pragma unroll
                for (int i2 = 0; i2 < 4; ++i2) cs[it][i2] = rr[i2]; }
            const float* gq = a.in[I_SWA_QN] + (size_t)l * 64 + 8 * s; const float* gk = a.in[I_SWA_KN] + (size_t)l * 64 + 8 * s; const float* gm = a.in[I_MOBA_QN] + (size_t)l * 64 + 8 * s;
            float g8q[8], g8k[8], g8m[8];
#pragma unroll
            for (int i = 0; i < 8; ++i) { g8q[i] = gq[i]; g8k[i] = gk[i]; g8m[i] = gm[i]; }
#pragma unroll 1
            for (int h0 = 0; h0 < 28; h0 += 7) {
                u32x4 raw[7][2]; bf16_t* ptr[7][2];
#pragma unroll
                for (int k = 0; k < 7; ++k) { const int hs = h0 + k;
                    const int col = hs < 16 ? QB_OFF + 64 * hs : (hs < 18 ? KB_OFF + 64 * (hs - 16) : QM_OFF + 64 * (hs - 18));
#pragma unroll
                    for (int it = 0; it < 2; ++it) { ptr[k][it] = PROJ + (tb + grp + 64 * it) * PW + col + 8 * s; if (hs < 26) raw[k][it] = *(const u32x4*)ptr[k][it]; } }
                asm volatile("" ::: "memory");
#pragma unroll
                for (int k = 0; k < 7; ++k) { const int hs = h0 + k;
                    if (hs < 26) {
#pragma unroll
                        for (int it = 0; it < 2; ++it) { float y[8];
                            if (hs < 16) qk_norm_rope8(ptr[k][it], raw[k][it], g8q, cs[it], s, y); else if (hs < 18) qk_norm_rope8(ptr[k][it], raw[k][it], g8k, cs[it], s, y); else qk_norm_rope8(ptr[k][it], raw[k][it], g8m, cs[it], s, y); } } }
            }
        }
        {
            const int h = F.wave, gi = F.lane >> 3;
            const float* gp = a.in[I_MOBA_KN] + (size_t)l * 64 + 8 * s;
            float g8[8], acc8[8];
#pragma unroll
            for (int i = 0; i < 8; ++i) { g8[i] = gp[i]; acc8[i] = 0.f; }
#pragma unroll 1
            for (int it0 = 0; it0 < 16; it0 += 4) {
                u32x4 raw[4]; f32x4 cs[4][4]; bf16_t* ptr[4];
#pragma unroll
                for (int k = 0; k < 4; ++k) { const int tok = gi + 8 * (it0 + k); ptr[k] = PROJ + (tb + tok) * PW + KM_OFF + 64 * h + 8 * s; raw[k] = *(const u32x4*)ptr[k];
                    const f32x4* rr = (const f32x4*)(rope + (size_t)(t0 + tok) * 32 + 8 * (s & 3));
#pragma unroll
                    for (int i2 = 0; i2 < 4; ++i2) cs[k][i2] = rr[i2]; }
                asm volatile("" ::: "memory");
#pragma unroll
                for (int k = 0; k < 4; ++k) { float y[8]; qk_norm_rope8(ptr[k], raw[k], g8, cs[k], s, y);
#pragma unroll
                    for (int i = 0; i < 8; ++i) acc8[i] += y[i]; }
            }
#pragma unroll
            for (int i = 0; i < 8; ++i) { acc8[i] += __shfl_xor(acc8[i], 8); acc8[i] += __shfl_xor(acc8[i], 16); acc8[i] += __shfl_xor(acc8[i], 32); }
            if (gi == 0) { float* kp = KMP + ((size_t)(b * 128 + (t0 >> 7)) * 8 + h) * 64 + 8 * s;
#pragma unroll
                for (int i = 0; i < 8; ++i) kp[i] = acc8[i]; }
        }
#pragma unroll 1
        for (int g = 0; g < 4; ++g) {
            const int w = 2 << g;
            __syncthreads();
#pragma unroll
            for (int k = 0; k < 4; ++k) {
                const int idx = F.tid + NTHR * k, tok = idx >> 4, ch = idx & 15; const int pos = t0 + tok; const int cnt = (pos + 1 < w) ? pos + 1 : w;
                const bf16_t* xp = PROJ + (tb + tok) * PW + XA_OFF + 128 * g + 8 * ch;
                float sum[8], x0[8];
#pragma unroll
                for (int i = 0; i < 8; ++i) sum[i] = 0.f;
#pragma unroll 2
                for (int i = 0; i < w; i += 2) {
                    u32x4 r0 = {0u, 0u, 0u, 0u}, r1 = {0u, 0u, 0u, 0u};
                    if (i < cnt) r0 = *(const u32x4*)(xp - (size_t)i * PW);
                    if (i + 1 < cnt) r1 = *(const u32x4*)(xp - (size_t)(i + 1) * PW);
                    const float v0[8] = {bflo(r0.x), bfhi(r0.x), bflo(r0.y), bfhi(r0.y), bflo(r0.z), bfhi(r0.z), bflo(r0.w), bfhi(r0.w)};
                    const float v1[8] = {bflo(r1.x), bfhi(r1.x), bflo(r1.y), bfhi(r1.y), bflo(r1.z), bfhi(r1.z), bflo(r1.w), bfhi(r1.w)};
#pragma unroll
                    for (int q = 0; q < 8; ++q) { sum[q] += v0[q] + v1[q]; if (i == 0) x0[q] = v0[q]; }
                }
                const float rc = 1.0f / (float)cnt;
                u32x4 o; o.x = pk2(sum[0] * rc - x0[0], sum[1] * rc - x0[1]); o.y = pk2(sum[2] * rc - x0[2], sum[3] * rc - x0[3]);
                o.z = pk2(sum[4] * rc - x0[4], sum[5] * rc - x0[5]); o.w = pk2(sum[6] * rc - x0[6], sum[7] * rc - x0[7]);
                *(LAS u32x4*)(PT + tok * 136 + 8 * ch) = o;
            }
            __syncthreads();
            const int r16 = F.lane & 15, kg = F.lane >> 4;
            bf16x8 af[4];
#pragma unroll
            for (int ks = 0; ks < 4; ++ks) af[ks] = *(const LAS bf16x8*)(PT + (16 * F.wave + r16) * 136 + 32 * ks + 8 * kg);
#pragma unroll
            for (int nt = 0; nt < 8; ++nt) {
                f32x4 acc = {0.f, 0.f, 0.f, 0.f};
#pragma unroll
                for (int ks = 0; ks < 4; ++ks) { const bf16x8 bfr = *(const bf16x8*)(POOLW + ((size_t)g * 128 + 16 * nt + r16) * 128 + 32 * ks + 8 * kg);
                    acc = __builtin_amdgcn_mfma_f32_16x16x32_bf16(bfr, af[ks], acc, 0, 0, 0); }
                const int e0 = 128 * g + 16 * nt + 4 * kg; const f32x4 sc = *(const f32x4*)(pscale + e0);
                constexpr float ms = (float)(1 << F8_MSH);
                *(unsigned*)(YA + (tb + 16 * F.wave + r16) * 2048 + e0) = pk4_fp8(acc[0] * sc[0] * ms, acc[1] * sc[1] * ms, acc[2] * sc[2] * ms, acc[3] * sc[3] * ms);
            }
        }
        __syncthreads();
    }
#undef a
}

typedef short v4i16_t __attribute__((ext_vector_type(4)));
__device__ __forceinline__ s16x4 vtr(const LAS unsigned char* p) { return __builtin_bit_cast(s16x4, __builtin_amdgcn_ds_read_tr16_b64_v4i16((LAS v4i16_t*)p)); }
__device__ __forceinline__ void load_kv256(LAS unsigned char* kb, LAS unsigned char* vb, const bf16_t* ksrc, const bf16_t* vsrc, int tid, int zero_rows) {
#pragma unroll
    for (int it = 0; it < 4; ++it) {
        const int i = tid + NTHR * it, key = i >> 3, c = i & 7;
        u32x4 kv = {0u, 0u, 0u, 0u}, vv = {0u, 0u, 0u, 0u};
        if (key >= zero_rows) { kv = *(const u32x4*)(ksrc + (size_t)key * PW + 8 * c); vv = *(const u32x4*)(vsrc + (size_t)key * PW + 8 * c); }
        *(LAS u32x4*)(kb + c * 4096 + ((key ^ c) << 4)) = kv;
        *(LAS u32x4*)(vb + (c >> 2) * 16384 + key * 64 + (c & 3) * 16) = vv;
    }
}
__device__ __forceinline__ float score_bound(const float* gq, const float* gk, int lane) {
    float a = fabsf(gq[lane]), b = fabsf(gk[lane]);
#pragma unroll
    for (int o = 1; o < 64; o <<= 1) { a = fmaxf(a, __shfl_xor(a, o)); b = fmaxf(b, __shfl_xor(b, o)); }
    return 64.0f * C2 * 1.02f * a * b;
}
template <int NT, int MASK>
__device__ __forceinline__ void attn_step(const LAS unsigned char* kb, const LAS unsigned char* vb, const int kt0, const bf16x8 (&q)[4], f32x16 (&o)[2], float& m, float& l,
                                          const int lane, const int qt, const bool blk0) {
    const int r32 = lane & 31, hi = lane >> 5;
    f32x16 p[NT];
#pragma unroll
    for (int i = 0; i < NT; ++i)
#pragma unroll
        for (int r = 0; r < 16; ++r) p[i][r] = 0.f;
#pragma unroll
    for (int s = 0; s < 4; ++s)
#pragma unroll
        for (int i = 0; i < NT; ++i) { const int key = 32 * (kt0 + i) + r32, ch = 2 * s + hi;
            const bf16x8 kf = *(const LAS bf16x8*)(kb + ch * 4096 + ((key ^ ch) << 4));
            p[i] = __builtin_amdgcn_mfma_f32_32x32x16_bf16(kf, q[s], p[i], 0, 0, 0); }
    const int qw = 32 * qt + r32;
    if (MASK != 0) {
#pragma unroll
        for (int i = 0; i < NT; ++i)
#pragma unroll
            for (int r = 0; r < 16; ++r) { const int kw = 32 * (kt0 + i) + (r & 3) + 8 * (r >> 2) + 4 * hi;
                const bool ok = (MASK == 1) ? (kw > qw && kw <= qw + 128 && (!blk0 || kw >= 128)) : (kw <= qw);
                p[i][r] = ok ? p[i][r] : -INFINITY; }
    }
    const float nm = -m;
    float ps = 0.f;
#pragma unroll
    for (int i = 0; i < NT; ++i)
#pragma unroll
        for (int r = 0; r < 16; ++r) { const float e = __builtin_amdgcn_exp2f(__builtin_fmaf(p[i][r], C2, nm)); p[i][r] = e; ps += e; }
    l += ps;
    const int vlane = (4 * hi + ((lane & 15) >> 2)) * 64 + ((lane >> 4) & 1) * 32 + (lane & 3) * 8;
#pragma unroll
    for (int i = 0; i < NT; ++i) {
        u32x4 pw[2];
#pragma unroll
        for (int s2 = 0; s2 < 2; ++s2) { pw[s2].x = cvt_pk_bf16(p[i][8 * s2 + 0], p[i][8 * s2 + 1]); pw[s2].y = cvt_pk_bf16(p[i][8 * s2 + 2], p[i][8 * s2 + 3]);
            pw[s2].z = cvt_pk_bf16(p[i][8 * s2 + 4], p[i][8 * s2 + 5]); pw[s2].w = cvt_pk_bf16(p[i][8 * s2 + 6], p[i][8 * s2 + 7]); }
#pragma unroll
        for (int s2 = 0; s2 < 2; ++s2)
#pragma unroll
            for (int d0 = 0; d0 < 2; ++d0) {
                const LAS unsigned char* vp = vb + d0 * 16384 + (32 * (kt0 + i) + 16 * s2) * 64 + vlane;
                const s16x4 lo = vtr(vp), hi4 = vtr(vp + 512);
                const bf16x8 vf = {lo[0], lo[1], lo[2], lo[3], hi4[0], hi4[1], hi4[2], hi4[3]};
                o[d0] = __builtin_amdgcn_mfma_f32_32x32x16_bf16(vf, __builtin_bit_cast(bf16x8, pw[s2]), o[d0], 0, 0, 0); }
    }
}

#define SELIDX(t, h) ((((size_t)(t) >> 14) * 8 + (size_t)(h)) * SEQ + ((size_t)(t) & (SEQ - 1)))
__device__ __forceinline__ void gate_unit(const Frame& F, int b, int j, int hp) {
    const bf16_t* PROJ = (const bf16_t*)(F.ws + WS_PROJ);
    const float* KMP = (const float*)(F.ws + WS_KMP);
    unsigned* SEL = (unsigned*)(F.ws + WS_SEL);
    LAS unsigned char* km = F.lds;
    __syncthreads();
    for (int i = F.tid; i < j * 128; i += NTHR) { const int n = i >> 7, rem = i & 127, hh = rem >> 6, d = rem & 63, h2 = hp * 2 + hh;
        const float v = (KMP[((size_t)(b * 128 + 2 * n) * 8 + h2) * 64 + d] + KMP[((size_t)(b * 128 + 2 * n + 1) * 8 + h2) * 64 + d]) * (1.0f / 256.0f);
        const unsigned vh = f2bf(v); const float rest = v - __builtin_bit_cast(float, vh << 16);
        LAS bf16_t* p = (LAS bf16_t*)(km + hh * 16384 + (d >> 3) * 1024 + n * 16 + (d & 7) * 2);
        p[0] = (bf16_t)vh; p[4096] = (bf16_t)f2bf(rest); }
    __syncthreads();
    const int lane = F.lane, r32 = lane & 31, hi = lane >> 5, hh = F.wave >> 2, h = hp * 2 + hh;
    const LAS unsigned char* kmh = km + hh * 16384;
    const int ngrp = (j + 31) >> 5;
#pragma unroll 1
    for (int tile = 0; tile < 2; ++tile) {
        const size_t t = (size_t)b * SEQ + 256 * j + (F.wave & 3) * 64 + 32 * tile + r32;
        bf16x8 q[4];
#pragma unroll
        for (int s = 0; s < 4; ++s) q[s] = *(const bf16x8*)(PROJ + t * PW + QM_OFF + 64 * h + 16 * s + 8 * hi);
        float v0 = -INFINITY, v1 = -INFINITY, v2 = -INFINITY; unsigned i0 = 255u, i1 = 255u, i2 = 255u;
#pragma unroll 1
        for (int g = 0; g < ngrp; ++g) {
            f32x16 p;
#pragma unroll
            for (int r = 0; r < 16; ++r) p[r] = 0.f;
#pragma unroll
            for (int s = 0; s < 4; ++s)
#pragma unroll
                for (int part = 0; part < 2; ++part) { const bf16x8 kf = *(const LAS bf16x8*)(kmh + part * 8192 + (2 * s + hi) * 1024 + ((32 * g + r32) << 4));
                    p = __builtin_amdgcn_mfma_f32_32x32x16_bf16(kf, q[s], p, 0, 0, 0); }
#pragma unroll
            for (int r = 0; r < 16; ++r) { const int n = 32 * g + (r & 3) + 8 * (r >> 2) + 4 * hi;
                const float dv = (n < j) ? p[r] : -INFINITY;
                if (dv > v0) { v2 = v1; i2 = i1; v1 = v0; i1 = i0; v0 = dv; i0 = (unsigned)n; }
                else if (dv > v1) { v2 = v1; i2 = i1; v1 = dv; i1 = (unsigned)n; }
                else if (dv > v2) { v2 = dv; i2 = (unsigned)n; } }
        }
        const float w0 = __shfl_xor(v0, 32), w1 = __shfl_xor(v1, 32), w2 = __shfl_xor(v2, 32);
        const unsigned k0 = __shfl_xor(i0, 32), k1 = __shfl_xor(i1, 32), k2 = __shfl_xor(i2, 32);
#define GINS(dv, n) do { const float dv_ = (dv); const unsigned n_ = (n); \
            if (dv_ > v0 || (dv_ == v0 && n_ < i0)) { v2 = v1; i2 = i1; v1 = v0; i1 = i0; v0 = dv_; i0 = n_; } \
            else if (dv_ > v1 || (dv_ == v1 && n_ < i1)) { v2 = v1; i2 = i1; v1 = dv_; i1 = n_; } \
            else if (dv_ > v2 || (dv_ == v2 && n_ < i2)) { v2 = dv_; i2 = n_; } } while (0)
        GINS(w0, k0); GINS(w1, k1); GINS(w2, k2);
#undef GINS
        if (hi == 0) SEL[SELIDX(t, h)] = i0 | (i1 << 8) | (i2 << 16) | 0xFF000000u;
    }
}
__device__ __forceinline__ void swa_unit(const Frame& F, int l, int b, int g, int blk) {
    const bf16_t* PROJ = (const bf16_t*)(F.ws + WS_PROJ);
    unsigned char* YB = F.ws + WS_YA + 512;
    LAS unsigned char* kb = F.lds; LAS unsigned char* vb = F.lds + 32768;
    const size_t tb = (size_t)b * SEQ + (size_t)blk * 128;
    __syncthreads();
    { const long long w0 = (long long)tb - 128;
      load_kv256(kb, vb, PROJ + w0 * PW + KB_OFF + 64 * g, PROJ + w0 * PW + VB_OFF + 64 * g, F.tid, blk == 0 ? 128 : 0); }
    __syncthreads();
    const int head = g * 8 + F.wave, lane = F.lane, r32 = lane & 31, hi = lane >> 5;
    const float sink2 = F.ap->in[I_SWA_SINKS][l * 16 + head] * LOG2E;
    const float sbound = score_bound(F.ap->in[I_SWA_QN] + (size_t)l * 64, F.ap->in[I_SWA_KN] + (size_t)l * 64, lane);
    for (int qt = 0; qt < 4; ++qt) {
        const size_t tq = tb + 32 * qt + r32;
        bf16x8 q[4];
#pragma unroll
        for (int s = 0; s < 4; ++s) q[s] = *(const bf16x8*)(PROJ + tq * PW + QB_OFF + 64 * head + 16 * s + 8 * hi);
        f32x16 o[2];
#pragma unroll
        for (int r = 0; r < 16; ++r) { o[0][r] = 0.f; o[1][r] = 0.f; }
        float m = fmaxf(sbound, sink2), lsum = (hi == 0) ? __builtin_amdgcn_exp2f(sink2 - m) : 0.0f;
        if (blk == 0) {
            attn_step<2, 1>(kb, vb, qt, q, o, m, lsum, lane, qt, true);
            attn_step<2, 1>(kb, vb, qt + 2, q, o, m, lsum, lane, qt, true);
            attn_step<1, 1>(kb, vb, qt + 4, q, o, m, lsum, lane, qt, true);
        } else {
            attn_step<1, 1>(kb, vb, qt, q, o, m, lsum, lane, qt, false);
            attn_step<2, 0>(kb, vb, qt + 1, q, o, m, lsum, lane, qt, false);
            attn_step<1, 0>(kb, vb, qt + 3, q, o, m, lsum, lane, qt, false);
            attn_step<1, 1>(kb, vb, qt + 4, q, o, m, lsum, lane, qt, false);
        }
        lsum += __shfl_xor(lsum, 32);
        const float inv = (float)(1 << F8_MSH) / lsum;
        unsigned char* op = YB + tq * 2048 + 64 * head + 4 * hi;
#pragma unroll
        for (int d0 = 0; d0 < 2; ++d0)
#pragma unroll
            for (int g4 = 0; g4 < 4; ++g4) *(unsigned*)(op + 32 * d0 + 8 * g4) = pk4_fp8(o[d0][4 * g4] * inv, o[d0][4 * g4 + 1] * inv, o[d0][4 * g4 + 2] * inv, o[d0][4 * g4 + 3] * inv);
    }
}
__device__ __forceinline__ void gate_swa_phase(const Frame& F, int l) {
    for (int u = F.bid; u < 1024; u += F.G) {
        if (u < 512) { const int idx = u >> 2, hp = u & 3, b = idx >> 6, jj = idx & 63, j = b == 0 ? jj : 63 - jj; gate_unit(F, b, j, hp); }
        else { const int v = u - 512, b = v >> 8, g = (v >> 7) & 1, blk = v & 127; swa_unit(F, l, b, g, blk); }
    }
    __syncthreads();
}

__device__ __forceinline__ void moba_sel_phase(const Frame& F, int l, int rep) {
    const bf16_t* PROJ = (const bf16_t*)(F.ws + WS_PROJ);
    const unsigned* SEL = (const unsigned*)(F.ws + WS_SEL);
    float* ML = (float*)(F.ws + WS_ML); bf16_t* OPART = (bf16_t*)(F.ws + WS_OPART);
    LAS unsigned char* kb = F.lds; LAS unsigned char* vb = F.lds + 32768;
    LAS unsigned* list = (LAS unsigned*)(F.lds + 65536);
    volatile LAS unsigned* misc = (volatile LAS unsigned*)(F.lds + MISC_OFF);
    const int lane = F.lane, r32 = lane & 31, hi = lane >> 5;
    const float sbound = score_bound(F.ap->in[I_MOBA_QN] + (size_t)l * 64, F.ap->in[I_MOBA_KN] + (size_t)l * 64, lane);
    for (;;) {
        __syncthreads();
        if (F.tid == 0) misc[16] = __hip_atomic_fetch_add(F.ctl + CW_Q + 64 * l + 32 * rep, 1u, RLX_AGENT);
        __syncthreads();
        const int u = (int)misc[16];
        if (u >= 63 * 16) break;
        const int bh = u & 15, n = u >> 4, b = bh >> 3, h = bh & 7;
        const size_t tbat = (size_t)b * SEQ;
        load_kv256(kb, vb, PROJ + (tbat + 256 * n) * PW + KM_OFF + 64 * h, PROJ + (tbat + 256 * n) * PW + VM_OFF + 64 * h, F.tid, 0);
        const int s_first = 256 * (n + 1);
        for (int c = s_first >> 12; c < 4; ++c) {
            __syncthreads();
            if (F.tid == 0) misc[17] = 0u;
            __syncthreads();
#pragma unroll
            for (int k = 0; k < 8; ++k) { const int sl = F.tid + NTHR * k, s = 4096 * c + sl;
                if (s >= s_first) { const unsigned w = SEL[SELIDX(tbat + s, h)];
#pragma unroll
                    for (int slot = 0; slot < 3; ++slot) if (((w >> (8 * slot)) & 255u) == (unsigned)n) { const unsigned idx = atomicAdd((unsigned*)&misc[17], 1u); list[idx] = (unsigned)sl | ((unsigned)slot << 16); } } }
            __syncthreads();
            const int count = (int)misc[17];
            const int ntile = (count + 31) >> 5;
            for (int tile = F.wave; tile < ntile; tile += NWAVES) {
                const int idx = tile * 32 + r32; const bool valid = idx < count;
                const unsigned ent = list[valid ? idx : 0];
                const int s = 4096 * c + (int)(ent & 0xffffu), slot = (int)(ent >> 16);
                const size_t tq = tbat + s;
                bf16x8 q[4];
#pragma unroll
                for (int st = 0; st < 4; ++st) q[st] = *(const bf16x8*)(PROJ + tq * PW + QM_OFF + 64 * h + 16 * st + 8 * hi);
                f32x16 o[2];
#pragma unroll
                for (int r = 0; r < 16; ++r) { o[0][r] = 0.f; o[1][r] = 0.f; }
                float m = sbound, lsum = 0.f;
#pragma unroll 1
                for (int kt = 0; kt < 8; kt += 2) attn_step<2, 0>(kb, vb, kt, q, o, m, lsum, lane, 0, false);
                lsum += __shfl_xor(lsum, 32);
                if (valid) {
                    const size_t p = (tq * 8 + h) * 3 + slot;
                    if (hi == 0) { ML[p * 2] = m; ML[p * 2 + 1] = lsum; }
                    bf16_t* op = OPART + p * 64 + 4 * hi;
#pragma unroll
                    for (int d0 = 0; d0 < 2; ++d0)
#pragma unroll
                        for (int g4 = 0; g4 < 4; ++g4) { u32x2 w; w.x = cvt_pk_bf16(o[d0][4 * g4], o[d0][4 * g4 + 1]); w.y = cvt_pk_bf16(o[d0][4 * g4 + 2], o[d0][4 * g4 + 3]); *(u32x2*)(op + 32 * d0 + 8 * g4) = w; }
                }
            }
        }
    }
}
__device__ __forceinline__ void moba_own_phase(const Frame& F, int l) {
    const bf16_t* PROJ = (const bf16_t*)(F.ws + WS_PROJ);
    const unsigned* SEL = (const unsigned*)(F.ws + WS_SEL);
    const float* ML = (const float*)(F.ws + WS_ML); const bf16_t* OPART = (const bf16_t*)(F.ws + WS_OPART);
    unsigned char* YC = F.ws + WS_YA + 1536;
    const int lane = F.lane, r32 = lane & 31, hi = lane >> 5;
    const float sbound = score_bound(F.ap->in[I_MOBA_QN] + (size_t)l * 64, F.ap->in[I_MOBA_KN] + (size_t)l * 64, lane);
    for (int su = F.bid; su < 512; su += F.G) {
        __syncthreads();
#pragma unroll 1
        for (int which = 0; which < 2; ++which) { const int uu = su * 2 + which, bh = uu >> 6, j = uu & 63, b = bh >> 3, h = bh & 7; const size_t t0 = (size_t)b * SEQ + 256 * j;
            load_kv256(F.lds + which * 65536, F.lds + which * 65536 + 32768, PROJ + t0 * PW + KM_OFF + 64 * h, PROJ + t0 * PW + VM_OFF + 64 * h, F.tid, 0); }
        __syncthreads();
#pragma unroll 1
        for (int which = 0; which < 2; ++which) {
            const int uu = su * 2 + which, bh = uu >> 6, j = uu & 63, b = bh >> 3, h = bh & 7; const size_t t0 = (size_t)b * SEQ + 256 * j;
            const LAS unsigned char* kb = F.lds + which * 65536; const LAS unsigned char* vb = kb + 32768;
            const int qt = which == 0 ? F.wave : 7 - F.wave;
            const size_t tq = t0 + 32 * qt + r32;
            bf16x8 q[4];
#pragma unroll
            for (int st = 0; st < 4; ++st) q[st] = *(const bf16x8*)(PROJ + tq * PW + QM_OFF + 64 * h + 16 * st + 8 * hi);
            f32x16 o[2];
#pragma unroll
            for (int r = 0; r < 16; ++r) { o[0][r] = 0.f; o[1][r] = 0.f; }
            float m = sbound, lsum = 0.f;
            int kt = 0;
#pragma unroll 1
            for (; kt + 2 <= qt; kt += 2) attn_step<2, 0>(kb, vb, kt, q, o, m, lsum, lane, qt, false);
            if (kt < qt) attn_step<2, 2>(kb, vb, kt, q, o, m, lsum, lane, qt, false);
            else attn_step<1, 2>(kb, vb, qt, q, o, m, lsum, lane, qt, false);
            lsum += __shfl_xor(lsum, 32);
            const unsigned sw = SEL[SELIDX(tq, h)];
            float ms[3], ls[3]; float M = m;
#pragma unroll
            for (int slot = 0; slot < 3; ++slot) { const bool ok = ((sw >> (8 * slot)) & 255u) != 255u; const size_t p = (tq * 8 + h) * 3 + slot;
                ms[slot] = ok ? ML[p * 2] : -INFINITY; ls[slot] = ok ? ML[p * 2 + 1] : 0.f; M = fmaxf(M, ms[slot]); }
            const float w_own = __builtin_amdgcn_exp2f(m - M);
            float L = lsum * w_own;
#pragma unroll
            for (int r = 0; r < 16; ++r) { o[0][r] *= w_own; o[1][r] *= w_own; }
#pragma unroll
            for (int slot = 0; slot < 3; ++slot) {
                const float ws = __builtin_amdgcn_exp2f(ms[slot] - M);
                L += ls[slot] * ws;
                if (ms[slot] != -INFINITY) { const bf16_t* op = OPART + ((tq * 8 + h) * 3 + slot) * 64 + 4 * hi;
#pragma unroll
                    for (int d0 = 0; d0 < 2; ++d0)
#pragma unroll
                        for (int g4 = 0; g4 < 4; ++g4) { const u32x2 pv = *(const u32x2*)(op + 32 * d0 + 8 * g4);
                            o[d0][4 * g4] += ws * bflo(pv.x); o[d0][4 * g4 + 1] += ws * bfhi(pv.x); o[d0][4 * g4 + 2] += ws * bflo(pv.y); o[d0][4 * g4 + 3] += ws * bfhi(pv.y); } }
            }
            const float inv = (float)(1 << F8_MSH) / L;
            unsigned char* yp = YC + tq * 2048 + 64 * h + 4 * hi;
#pragma unroll
            for (int d0 = 0; d0 < 2; ++d0)
#pragma unroll
                for (int g4 = 0; g4 < 4; ++g4) *(unsigned*)(yp + 32 * d0 + 8 * g4) = pk4_fp8(o[d0][4 * g4] * inv, o[d0][4 * g4 + 1] * inv, o[d0][4 * g4 + 2] * inv, o[d0][4 * g4 + 3] * inv);
        }
    }
    __syncthreads();
}

__device__ __forceinline__ void route_phase(const Frame& F, int l) {
    const float* LOG = (const float*)(F.ws + WS_LOGITS);
    int* slot_tok = (int*)(F.ws + WS_SLOT_TOK); float* slot_w = (float*)(F.ws + WS_SLOT_W);
    int* tokr = (int*)(F.ws + WS_TOKR);
    LAS int* hist = (LAS int*)F.lds; LAS int* base = hist + 32;
    gu32* cnt = F.ctl + CW_CNT + 64 * l;
    for (int chunk = F.bid; chunk < T / 128; chunk += F.G) {
        __syncthreads();
        if (F.tid < 32) hist[F.tid] = 0;
        __syncthreads();
        int e0 = 0, e1 = 0, r0 = 0, r1 = 0; float w0 = 0.f, w1 = 0.f; const int t = chunk * 128 + F.tid;
        if (F.tid < 128) {
            const float* lg = LOG + (size_t)t * 64; const float* lg2 = lg + (size_t)T * 64;
            float gl[4]; const f32x4 g4 = *(const f32x4*)lg + *(const f32x4*)lg2; gl[0] = g4[0]; gl[1] = g4[1]; gl[2] = g4[2]; gl[3] = g4[3];
            int gs = 0; float gm = gl[0];
#pragma unroll
            for (int i = 1; i < 4; ++i) if (gl[i] > gm) { gm = gl[i]; gs = i; }
            float den = 0.f;
#pragma unroll
            for (int i = 0; i < 4; ++i) den += __expf(gl[i] - gm);
            const float pg = 1.0f / den;
            float el[8]; const f32x4 ea = *(const f32x4*)(lg + 4 + 8 * gs) + *(const f32x4*)(lg2 + 4 + 8 * gs), eb = *(const f32x4*)(lg + 8 + 8 * gs) + *(const f32x4*)(lg2 + 8 + 8 * gs);
            el[0] = ea[0]; el[1] = ea[1]; el[2] = ea[2]; el[3] = ea[3]; el[4] = eb[0]; el[5] = eb[1]; el[6] = eb[2]; el[7] = eb[3];
            int a0 = 0; float m0 = el[0];
#pragma unroll
            for (int i = 1; i < 8; ++i) if (el[i] > m0) { m0 = el[i]; a0 = i; }
            int a1 = -1; float m1 = -INFINITY;
#pragma unroll
            for (int i = 0; i < 8; ++i) if (i != a0 && el[i] > m1) { m1 = el[i]; a1 = i; }
            const float x1 = __expf(m1 - m0); const float inv = 1.0f / (1.0f + x1);
            w0 = pg * inv; w1 = pg * x1 * inv; e0 = gs * 8 + a0; e1 = gs * 8 + a1;
            r0 = atomicAdd((int*)&hist[e0], 1); r1 = atomicAdd((int*)&hist[e1], 1);
        }
        __syncthreads();
        if (F.tid < 32) { const int hc = hist[F.tid]; base[F.tid] = hc ? (int)__hip_atomic_fetch_add(cnt + F.tid, (unsigned)hc, RLX_AGENT) : 0; }
        __syncthreads();
        if (F.tid < 128) {
            r0 += base[e0]; r1 += base[e1];
            slot_tok[(size_t)e0 * CAP + r0] = t; slot_w[(size_t)e0 * CAP + r0] = w0;
            slot_tok[(size_t)e1 * CAP + r1] = t; slot_w[(size_t)e1 * CAP + r1] = w1;
            tokr[t * 4 + 0] = e0; tokr[t * 4 + 1] = r0; tokr[t * 4 + 2] = e1; tokr[t * 4 + 3] = r1;
        }
    }
    __syncthreads();
}

template <bool G1>
struct MoeSched {
    static constexpr bool GATHER = G1;
    const char* A; const char* B; const gu32* cnt; const LAS int* bb; const int* slot_tok; int Kb, G, c, nunits;
    __device__ __forceinline__ bool next(int i, pg8::Unit& u) const {
        const int L = i * G + c; if (L >= nunits) return false;
        int f = L; { const int q = nunits / 8, r = nunits % 8, xcd = f % 8, off = f / 8; f = (xcd < r ? xcd * (q + 1) : r * (q + 1) + (xcd - r) * q) + off; }
        const int cb = f >> 3; u.pn = f & 7; u.pm = cb;
        int e = 0;
#pragma unroll
        for (int st = 16; st >= 1; st >>= 1) { const int t2 = __builtin_amdgcn_readfirstlane(bb[e + st]); if (t2 <= cb) e += st; }
        const int b0 = __builtin_amdgcn_readfirstlane(bb[e]);
        const int ce = (int)__builtin_amdgcn_readfirstlane(__hip_atomic_load(cnt + e, RLX_AGENT));
        u.e = e; u.rank0 = (cb - b0) * 256; const int rem = ce - u.rank0; u.nrow = rem < 256 ? rem : 256;
        return true;
    }
    __device__ __forceinline__ const char* a_base(const pg8::Unit& u) const { return G1 ? A : A + (size_t)u.pm * 256 * Kb; }
    __device__ __forceinline__ const char* b_base(const pg8::Unit& u) const { return B + ((size_t)u.e * 2048 + (size_t)u.pn * 256) * Kb; }
    __device__ __forceinline__ unsigned gather(const pg8::Unit& u, int R) const { const int tok = (R < u.nrow) ? slot_tok[(size_t)u.e * CAP + u.rank0 + R] : 0; return (unsigned)tok * (unsigned)Kb; }
};

constexpr int PH_PER_LAYER = 13, N_PHASES = 2 * PH_PER_LAYER + 1;
#ifndef PHMASK
#define PHMASK 0xFFFFFFFFu
#endif
#define IN(k) (((PHMASK >> ((k) % PH_PER_LAYER)) & 1u) && lo <= (k) && (k) < hi)
#define SEAM(k) do { if (IN(k) && IN((k) + 1)) xcd_barrier(bar); } while (0)
#define PH_BEGIN() do { int t_ = threadIdx.x; asm volatile("" : "+v"(t_)); F.tid = t_; F.lane = t_ & 63; F.wave = __builtin_amdgcn_readfirstlane(t_ >> 6); \
        ArgsP ap_ = (ArgsP)__builtin_amdgcn_kernarg_segment_ptr(); asm volatile("" : "+s"(ap_)); F.ap = ap_; F.ws = ap_->ws; F.ctl = (gu32*)(ap_->ws + WS_CTL); } while (0)
#define REP(k) for (int rep_ = 0; rep_ < ((l == 0 && PROBE_DUP == (k)) ? 2 : 1); ++rep_)
#define AIN(i) (F.ap->in[i])
#define AOUT (F.ap->out)
#define WSB(off) (F.ws + (off))


template <int l>
__device__ __forceinline__ void layer_phases(Frame& F, const int lo, const int hi, const XcdBarrier& bar) {
        constexpr int pb = l * PH_PER_LAYER;
        if (IN(pb + 0)) REP(0) { PH_BEGIN(); if (rep_) xcd_barrier(bar);
            conv_phase(F, l);
            if (l == 0) norm_phase<0>(F, AIN(I_X), AOUT, AIN(I_NORM_MIX), nullptr);
            else norm_phase<2>(F, nullptr, AOUT, AIN(I_NORM_MIX) + (size_t)l * D, F.ctl + CW_CNT + 64 * (l - 1));
        }
        SEAM(pb + 0);
        if (IN(pb + 1)) REP(1) { PH_BEGIN(); if (rep_) xcd_barrier(bar);
            if (FP8_IN) { pg8::UnevenSched S{WSB(WS_H8), WSB(WS_WIN8), T / 256, 24, D, F.G, F.bid};
              pg8::EpiGate8 E{WSB(WS_G8A)};
              pg8::gemm_phase<pg8::EpiGate8, pg8::UnevenSched, true, true, true, 127 - F8_WSH, 127 - F8_HSH>(F.lds, D, S, E); }
            else { pg8::DenseSched S{WSB(WS_H), (const bf16_t*)WSB(WS_WIN) + (size_t)3328 * D, T / 256, 24, 2 * D, F.G, F.bid};
              pg8::EpiProj<true> E{(bf16_t*)WSB(WS_PROJ), 13};
              pg8::gemm_phase<pg8::EpiProj<true>, pg8::DenseSched, true, true>(F.lds, 2 * D, S, E); }
            PH_BEGIN();
            { pg8::DenseSched S{WSB(WS_X), WSB(WS_WIN), T / 256, 13, 2 * D, F.G, F.bid};
              pg8::EpiProj<false> E{(bf16_t*)WSB(WS_PROJ), 0, (const float*)WSB(WS_RS1)};
              pg8::gemm_phase<pg8::EpiProj<false>, pg8::DenseSched, true, true>(F.lds, 2 * D, S, E); }
        }
        SEAM(pb + 1);
        if (IN(pb + 2)) REP(2) { PH_BEGIN(); if (rep_) xcd_barrier(bar); prep_phase(F, l); }
        SEAM(pb + 2);
        if (IN(pb + 3)) REP(3) { PH_BEGIN(); if (rep_) xcd_barrier(bar); gate_swa_phase(F, l); }
        SEAM(pb + 3);
        if (IN(pb + 4)) REP(4) { PH_BEGIN(); if (rep_) xcd_barrier(bar); moba_sel_phase(F, l, rep_); }
        SEAM(pb + 4);
        if (IN(pb + 5)) REP(5) { PH_BEGIN(); if (rep_) xcd_barrier(bar); moba_own_phase(F, l); }
        SEAM(pb + 5);
        if (IN(pb + 6)) REP(6) { PH_BEGIN(); if (rep_) xcd_barrier(bar);
            static_assert(FP8_O == 1, "the fused up-projection writes the fp8 operand of the output projection");
            pg8::DenseSched S{WSB(WS_YA), WSB(WS_WUPA), T / 256, D / 256, D, F.G, F.bid}; pg8::EpiUpH E{WSB(WS_G8A), WSB(WS_H8)};
            pg8::gemm_phase<pg8::EpiUpH, pg8::DenseSched, true, true, true, 127 - F8_WSH, 127 - F8_MSH>(F.lds, D, S, E);
        }
        SEAM(pb + 6);
        if (IN(pb + 7)) REP(7) { PH_BEGIN(); if (rep_) xcd_barrier(bar);
            constexpr int EB = FP8_O ? 1 : 2; constexpr bool F8 = FP8_O != 0;
            pg8::DenseSched S{WSB(FP8_O ? WS_H8 : WS_MERGED), WSB(WS_WO), T / 256, D / 256, EB * D, F.G, F.bid};
            { pg8::EpiResid<false> E{nullptr, (bf16_t*)WSB(WS_X)}; pg8::gemm_phase<pg8::EpiResid<false>, pg8::DenseSched, true, true, F8, 127 - F8_WSH, 127 - F8_HSH>(F.lds, EB * D, S, E); }
        }
        SEAM(pb + 7);
        if (IN(pb + 8)) REP(8) { PH_BEGIN(); if (rep_) xcd_barrier(bar); norm_phase<1>(F, nullptr, AOUT, AIN(I_NORM_FFN) + (size_t)l * D, nullptr); }
        SEAM(pb + 8);
        if (IN(pb + 9)) REP(9) { PH_BEGIN(); if (rep_) xcd_barrier(bar);
            pg8::SplitKSched S{WSB(WS_X), WSB(WS_WR), T / 256, 2 * D, F.G, F.bid};
            pg8::EpiLogits E{(float*)WSB(WS_LOGITS), (const float*)WSB(WS_RS2), 1.0f};
            pg8::gemm_phase<pg8::EpiLogits, pg8::SplitKSched, false, true>(F.lds, 2 * D, S, E, 16);
        }
        SEAM(pb + 9);
        if (IN(pb + 10)) REP(10) { PH_BEGIN(); if (rep_) xcd_barrier(bar); route_phase(F, l); }
        SEAM(pb + 10);
        if (IN(pb + 11)) REP(11) { PH_BEGIN(); if (rep_) xcd_barrier(bar);
            build_blkbase(F, F.ctl + CW_CNT + 64 * l);
            const LAS int* bb = (const LAS int*)(F.lds + MISC_OFF + 256);
            constexpr int EB = FP8_MOE ? 1 : 2;
            MoeSched<true> S{(const char*)WSB(FP8_MOE ? WS_H8 : WS_H), (const char*)WSB(WS_W13), F.ctl + CW_CNT + 64 * l, bb, (const int*)WSB(WS_SLOT_TOK), D * EB, F.G, F.bid, __builtin_amdgcn_readfirstlane(bb[32]) * 8};
            pg8::EpiAct<FP8_MOE != 0> E{WSB(WS_ACT)};
            pg8::gemm_phase<pg8::EpiAct<FP8_MOE != 0>, MoeSched<true>, true, true, FP8_MOE != 0, 127 - F8_WSH, 127 - F8_HSH>(F.lds, D * EB, S, E);
        }
        SEAM(pb + 11);
        if (IN(pb + 12)) REP(12) { PH_BEGIN(); if (rep_) xcd_barrier(bar);
            build_blkbase(F, F.ctl + CW_CNT + 64 * l);
            const LAS int* bb = (const LAS int*)(F.lds + MISC_OFF + 256);
            constexpr int EB = FP8_MOE ? 1 : 2;
            MoeSched<false> S{(const char*)WSB(WS_ACT), (const char*)WSB(WS_WD), F.ctl + CW_CNT + 64 * l, bb, (const int*)WSB(WS_SLOT_TOK), FF * EB, F.G, F.bid, __builtin_amdgcn_readfirstlane(bb[32]) * 8};
            pg8::EpiDown E{WSB(WS_Y), (const float*)WSB(WS_SLOT_W)};
            pg8::gemm_phase<pg8::EpiDown, MoeSched<false>, true, true, FP8_MOE != 0, 127 - F8_WSH, 127 - F8_ASH>(F.lds, FF * EB, S, E);
        }
        SEAM(pb + 12);
}

__global__ void __launch_bounds__(NTHR, 2) fwd(Args kargs) {
    extern __shared__ __attribute__((aligned(16))) unsigned char lds_raw[];
    Frame F;
    F.lds = (LAS unsigned char*)lds_raw; F.ap = (ArgsP)__builtin_amdgcn_kernarg_segment_ptr(); F.ws = F.ap->ws; F.ctl = (gu32*)(F.ws + WS_CTL);
    F.tid = threadIdx.x; F.lane = F.tid & 63; F.wave = __builtin_amdgcn_readfirstlane(F.tid >> 6); F.G = gridDim.x; F.bid = blockIdx.x;
    for (int u = F.tid; u < (LDS_BYTES - MISC_OFF) / 4; u += NTHR) ((LAS unsigned*)(F.lds + MISC_OFF))[u] = 0u;
    __syncthreads();
    const int lo = kargs.ph_lo, hi = kargs.ph_hi;
    const bool fused = (hi - lo) > 1;
    XcdBarrier bar; bar.bar = (unsigned*)(F.ctl + CW_BAR); bar.x = 0; bar.st = nullptr;
    if (fused) bar = xcd_barrier_post((unsigned*)(F.ctl + CW_BAR), (volatile LAS unsigned*)(F.lds + MISC_OFF) + 8);
    layer_phases<0>(F, lo, hi, bar);
    layer_phases<1>(F, lo, hi, bar);
    if (IN(2 * PH_PER_LAYER)) { PH_BEGIN(); norm_phase<3>(F, nullptr, AOUT, nullptr, F.ctl + CW_CNT + 64 * (DEPTH - 1)); }
#undef IN
#undef SEAM
#undef PH_BEGIN
#undef AIN
#undef REP
#undef AOUT
#undef WSB
}

extern "C" void kernel_launch(void* const* d_in, const int* in_sizes, int n_in, void* d_out, int out_size, void* d_ws, size_t ws_size, hipStream_t stream) {
    static int grid = 0;
    if (grid == 0) {
        if (n_in != 20 || in_sizes[0] != T * D || out_size != T * D || ws_size < WS_END) { fprintf(stderr, "kernel_launch: unexpected shapes (n_in %d, in0 %d, out %d, ws %zu < %zu)\n", n_in, n_in > 0 ? in_sizes[0] : -1, out_size, ws_size, (size_t)WS_END); grid = -1; return; }
        int dev = 0, cus = 0, per_cu = 0;
        if (hipGetDevice(&dev) != hipSuccess || hipDeviceGetAttribute(&cus, hipDeviceAttributeMultiprocessorCount, dev) != hipSuccess) { grid = -1; return; }
        if (hipFuncSetAttribute((const void*)fwd, hipFuncAttributeMaxDynamicSharedMemorySize, LDS_BYTES) != hipSuccess) { fprintf(stderr, "kernel_launch: hipFuncSetAttribute failed\n"); grid = -1; return; }
        if (hipOccupancyMaxActiveBlocksPerMultiprocessor(&per_cu, (const void*)fwd, NTHR, LDS_BYTES) != hipSuccess || per_cu < 1) fprintf(stderr, "kernel_launch: occupancy query says %d\n", per_cu);
        (void)hipGetLastError();
        grid = cus;
    }
    if (grid < 0) return;
    (void)hipMemsetAsync((char*)d_ws + WS_CTL, 0, CTL_ZERO_BYTES, stream);
    Args a{};
    for (int i = 0; i < 20; ++i) a.in[i] = (const float*)d_in[i];
    a.out = (float*)d_out; a.ws = (unsigned char*)d_ws;
    for (int i = 0; i < 32; ++i) a.inv_freq[i] = 1.0f / powf(10000.0f, (float)(2 * i) / 64.0f);
#if MK_N_LAUNCHES == 1
    a.ph_lo = 0; a.ph_hi = N_PHASES;
    hipLaunchKernelGGL(fwd, dim3(grid), dim3(NTHR), LDS_BYTES, stream, a);
#else
    for (int p = 0; p < N_PHASES; ++p) { a.ph_lo = p; a.ph_hi = p + 1; hipLaunchKernelGGL(fwd, dim3(grid), dim3(NTHR), LDS_BYTES, stream, a); }
#endif
}
```

```cpp
#include <hip/hip_runtime.h>
#include <cstdio>
#include <cstdint>

#ifndef MK_N_LAUNCHES
#define MK_N_LAUNCHES 1
#endif

#ifndef FP8_MOE
#define FP8_MOE 1
#endif
#ifndef FP8_IN
#define FP8_IN 1
#endif
#ifndef FP8_O
#define FP8_O 1
#endif
#ifndef PROBE_DUP
#define PROBE_DUP -1
#endif

#define LAS __attribute__((address_space(3)))
#define GAS __attribute__((address_space(1)))
typedef unsigned short bf16_t;
typedef short bf16x8 __attribute__((ext_vector_type(8)));
typedef short s16x4 __attribute__((ext_vector_type(4)));
typedef float f32x2 __attribute__((ext_vector_type(2)));
typedef float f32x4 __attribute__((ext_vector_type(4)));
typedef float f32x16 __attribute__((ext_vector_type(16)));
typedef unsigned u32x2 __attribute__((ext_vector_type(2)));
typedef unsigned u32x4 __attribute__((ext_vector_type(4)));
typedef GAS unsigned gu32;
typedef int v8i32 __attribute__((ext_vector_type(8)));
typedef int v4i32 __attribute__((ext_vector_type(4)));

constexpr int BATCH = 2, SEQ = 16384, T = BATCH * SEQ, D = 2048, DEPTH = 2;
constexpr int PW = 9472;
constexpr int XA_OFF = 0, QB_OFF = 512, KB_OFF = 1536, VB_OFF = 1664, QM_OFF = 1792, KM_OFF = 2304, VM_OFF = 2816, G_OFF = 3328;
constexpr int NEXP = 32, FF = 1024, CAP = 65536;
constexpr int NWAVES = 8, NTHR = 512;
constexpr float RMS_EPS = 1e-6f;
constexpr float LOG2E = 1.4426950408889634f;
constexpr float C2 = 0.125f * LOG2E;

constexpr size_t MiB = 1u << 20;
constexpr size_t WS_CTL = 0, CTL_ZERO_BYTES = 1 * MiB;
constexpr size_t WS_ROPE = 2 * MiB;
constexpr size_t WS_KMP = 6 * MiB;
constexpr size_t WS_SEL = 7 * MiB;
constexpr size_t WS_ML = 8 * MiB;
constexpr size_t WS_TOKR = 16 * MiB;
constexpr size_t WS_RS1 = 16 * MiB + 512 * 1024, WS_RS2 = 16 * MiB + 640 * 1024;
constexpr size_t WS_SLOT_TOK = 17 * MiB;
constexpr size_t WS_SLOT_W = 25 * MiB;
constexpr size_t WS_LOGITS = 33 * MiB;
constexpr size_t WS_WIN = 49 * MiB;
constexpr size_t WS_WIN8 = 62 * MiB;
constexpr size_t WS_WUPA = 85 * MiB;
constexpr size_t WS_WO = 93 * MiB;
constexpr size_t WS_WR = 101 * MiB;
constexpr size_t WS_POOLW = 102 * MiB;
constexpr size_t WS_W13 = 104 * MiB;
constexpr size_t WS_WD = 360 * MiB;
constexpr size_t WS_G8A = 232 * MiB, WS_G8B = 296 * MiB, WS_G8C = 424 * MiB;
static_assert(WS_G8B == WS_G8A + 64 * MiB && WS_G8C == WS_G8A + 192 * MiB, "EpiGate8 branch offsets");
constexpr size_t WS_H = 488 * MiB;
constexpr size_t WS_PROJ = 617 * MiB;
constexpr size_t WS_ACT = 617 * MiB;
constexpr size_t WS_Y = 761 * MiB;
constexpr size_t WS_YA = 1209 * MiB;
constexpr size_t WS_MERGED = 1337 * MiB;
constexpr size_t WS_OPART = 1465 * MiB;
constexpr size_t WS_H8 = 1657 * MiB;
constexpr size_t WS_X = 1721 * MiB;
constexpr size_t WS_END = 1849 * MiB;
static_assert(WS_PROJ + (size_t)T * PW * 2 <= WS_YA && WS_Y + (size_t)73728 * 2048 * 2 <= WS_YA && WS_WIN8 + (size_t)6144 * D <= WS_WUPA, "ws map");

constexpr int CW_TMO = 0;
constexpr int CW_BAR = 4096;
constexpr int CW_CNT = 8192;
constexpr int CW_Q = 8448;

constexpr int RING_BYTES = 131072;
constexpr int MISC_OFF = RING_BYTES;
constexpr int LDS_BYTES = 147456;

__device__ __forceinline__ unsigned f2bf(float f) { unsigned u = __builtin_bit_cast(unsigned, f); return (u + 0x7fffu + ((u >> 16) & 1u)) >> 16; }
__device__ __forceinline__ unsigned pk2(float lo, float hi) { return f2bf(lo) | (f2bf(hi) << 16); }
__device__ __forceinline__ float bflo(unsigned w) { return __builtin_bit_cast(float, w << 16); }
__device__ __forceinline__ float bfhi(unsigned w) { return __builtin_bit_cast(float, w & 0xffff0000u); }
typedef __bf16 bf16x2_t __attribute__((ext_vector_type(2)));
__device__ __forceinline__ unsigned cvt_pk_bf16(float lo, float hi) { const f32x2 v = {lo, hi}; const bf16x2_t b = __builtin_convertvector(v, bf16x2_t); return __builtin_bit_cast(unsigned, b); }
constexpr int F8_WSH = 5, F8_HSH = 3, F8_ASH = 2, F8_YSH = 6, F8_MSH = 4;
__device__ __forceinline__ float clamp448(float v) { return __builtin_fminf(__builtin_fmaxf(v, -448.f), 448.f); }
__device__ __forceinline__ unsigned pk4_fp8(float a, float b, float c, float d) {
    int p = 0; p = __builtin_amdgcn_cvt_pk_fp8_f32(clamp448(a), clamp448(b), p, false); p = __builtin_amdgcn_cvt_pk_fp8_f32(clamp448(c), clamp448(d), p, true); return (unsigned)p; }
__device__ __forceinline__ float clamp40(float v) { return __builtin_fminf(__builtin_fmaxf(v, -40.f), 40.f); }
__device__ __forceinline__ unsigned pk4_fp8_c40(float a, float b, float c, float d) {
    int p = 0; p = __builtin_amdgcn_cvt_pk_fp8_f32(clamp40(a), clamp40(b), p, false); p = __builtin_amdgcn_cvt_pk_fp8_f32(clamp40(c), clamp40(d), p, true); return (unsigned)p; }
#define LDS_WAIT() asm volatile("s_waitcnt lgkmcnt(0)" ::: "memory")
#define VM_WAIT() asm volatile("s_waitcnt vmcnt(0)" ::: "memory")
#define RLX_AGENT __ATOMIC_RELAXED, __HIP_MEMORY_SCOPE_AGENT

namespace pg8 {
constexpr int BM = 256, BK = 64, HALF = 128, HTB = HALF * BK * 2, STAGE_BYTES = 8 * HTB, NXCD = 8, WGM = 8;
__host__ __device__ __forceinline__ int lds_byte(int r, int c) { const int st = (r >> 4) * 2 + (c >> 5), rr = r & 15, cc = c & 31, ob = rr * 64 + cc * 2; return st * 1024 + (ob ^ (((ob >> 9) & 1) << 5)); }
__host__ __device__ __forceinline__ void stage_rc(int b, int& R, int& C) { const int st = b / 1024, sb = b % 1024, swz = sb ^ (((sb >> 9) & 1) << 5); R = (st >> 1) * 16 + swz / 64; C = (st & 1) * 32 + (swz % 64) / 2; }
__host__ __device__ __forceinline__ int perm32(int rho) { const int n = rho >> 4, i = rho & 15; return 8 * (i >> 2) + 4 * n + (i & 3); }

struct Unit { int pm, pn, e, nrow, rank0; };

__device__ __forceinline__ bool static_tile(int nM, int nN, int G, int c, int i, int& pm, int& pn) {
    const int nwg = nM * nN; const long L = (long)i * G + c; if (L >= nwg) return false;
    int wgid = (int)L; { const int q = nwg / NXCD, r = nwg % NXCD, xcd = wgid % NXCD, off = wgid / NXCD; wgid = (xcd < r ? xcd * (q + 1) : r * (q + 1) + (xcd - r) * q) + off; }
    const int nig = WGM * nN, gid = wgid / nig, fm = gid * WGM, gsz = (nM - fm) < WGM ? (nM - fm) : WGM;
    pm = fm + ((wgid % nig) % gsz); pn = (wgid % nig) / gsz; return true;
}
struct UnevenSched {
    static constexpr bool GATHER = false;
    const void* A; const void* Bt; int nM, nN, Kb, G, c;
    __device__ __forceinline__ bool next(int i, Unit& u) const {
        u.e = 0; u.nrow = 256; u.rank0 = 0;
        if (G != 256) return static_tile(nM, nN, G, c, i, u.pm, u.pn);
        int L;
        if (i < 11) L = i * 256 + c; else if (c >= 128 && i < 13) L = 2816 + 2 * (c - 128) + (i - 11); else return false;
        return static_tile(nM, nN, nM * nN, L, 0, u.pm, u.pn);
    }
    __device__ __forceinline__ const char* a_base(const Unit& u) const { return (const char*)A + (size_t)u.pm * 256 * Kb; }
    __device__ __forceinline__ const char* b_base(const Unit& u) const { return (const char*)Bt + (size_t)u.pn * 256 * Kb; }
    __device__ __forceinline__ unsigned gather(const Unit&, int) const { return 0u; }
};
struct SplitKSched {
    static constexpr bool GATHER = false;
    const void* A; const void* Bt; int nM, Kb, G, c;
    __device__ __forceinline__ bool next(int i, Unit& u) const { const int L = i * G + c; if (L >= 2 * nM) return false; u.pm = L >> 1; u.pn = L & 1; u.e = 0; u.nrow = 256; u.rank0 = 0; return true; }
    __device__ __forceinline__ const char* a_base(const Unit& u) const { return (const char*)A + (size_t)u.pm * 256 * Kb + (size_t)u.pn * (Kb / 2); }
    __device__ __forceinline__ const char* b_base(const Unit& u) const { return (const char*)Bt + (size_t)u.pn * (Kb / 2); }
    __device__ __forceinline__ unsigned gather(const Unit&, int) const { return 0u; }
};
struct DenseSched {
    static constexpr bool GATHER = false;
    const void* A; const void* Bt; int nM, nN, Kb, G, c;
    __device__ __forceinline__ bool next(int i, Unit& u) const { u.e = 0; u.nrow = 256; u.rank0 = 0; return static_tile(nM, nN, G, c, i, u.pm, u.pn); }
    __device__ __forceinline__ const char* a_base(const Unit& u) const { return (const char*)A + (size_t)u.pm * 256 * Kb; }
    __device__ __forceinline__ const char* b_base(const Unit& u) const { return (const char*)Bt + (size_t)u.pn * 256 * Kb; }
    __device__ __forceinline__ unsigned gather(const Unit&, int) const { return 0u; }
};

template <class E, class = void> struct HasMid { static constexpr bool v = false; };
template <class E> struct HasMid<E, decltype((void)E::MID)> { static constexpr bool v = E::MID; };
template <class Epi, class Sched, bool ALIGN_EPI = false, bool SP2 = true, bool FP8 = false, int SC_B = 127, int SC_A = 127>
__device__ __forceinline__ void gemm_phase(LAS unsigned char* lds, const int Kb, const Sched& S, const Epi& E, const int nt_override = 0) {
    int tid_ = threadIdx.x; asm volatile("" : "+v"(tid_));
    const int tid = tid_, wid = __builtin_amdgcn_readfirstlane(tid >> 6), lane = tid & 63, wr = wid >> 2, wc = wid & 3, fr = lane & 15, fq = lane >> 4;
    const int nt = nt_override ? nt_override : Kb / 128;
    constexpr bool GATHER = Sched::GATHER;
    int RA[2], CA[2]; unsigned voffB[2];
#pragma unroll
    for (int i = 0; i < 2; ++i) { int R, C; stage_rc(tid * 16 + i * 8192, R, C); RA[i] = R; CA[i] = C; const int Rb = Epi::PERM ? (64 * (R >> 5) + perm32(R & 31)) : R; voffB[i] = (unsigned)(Rb * Kb + C * 2); }
    const size_t kstep = (size_t)(BK * 2);
    const size_t hstepB = (size_t)(Epi::PERM ? 32 : HALF) * Kb;
    const size_t hstepA = GATHER ? (size_t)0 : (size_t)HALF * Kb;
    const unsigned ldsw = (unsigned)wid * 1024u;
    const int aoff = lds_byte(wr * 64 + fr, fq * 8), boff = lds_byte(wc * 32 + fr, fq * 8);
#define PG8_SA(b, h) (((b) * 2 + (h)) * HTB)
#define PG8_SB(b, h) ((4 + (b) * 2 + (h)) * HTB)
#define PG8_STAGE(bufoff, gbase, voff) do { _Pragma("unroll") for (int _i = 0; _i < 2; ++_i) \
        __builtin_amdgcn_global_load_lds((const unsigned*)((const char*)(gbase) + (voff)[_i]), (LAS unsigned*)(lds + (bufoff) + ldsw + _i * 8192), 16, 0, 0); } while (0)
#define PG8_LD8(base) __builtin_shufflevector(*(const LAS v4i32*)(base), *(const LAS v4i32*)((base) + 1024), 0, 1, 2, 3, 4, 5, 6, 7)
#define PG8_LDA(dst, b, h) do { _Pragma("unroll") for (int m = 0; m < 4; ++m) dst[m] = PG8_LD8(lds + PG8_SA(b, h) + aoff + m * 2048); } while (0)
#define PG8_LDB(dst, b, h) do { _Pragma("unroll") for (int n = 0; n < 2; ++n) dst[n] = PG8_LD8(lds + PG8_SB(b, h) + boff + n * 2048); } while (0)
#define PG8_LO(v) __builtin_bit_cast(bf16x8, __builtin_shufflevector(v, v, 0, 1, 2, 3))
#define PG8_HI(v) __builtin_bit_cast(bf16x8, __builtin_shufflevector(v, v, 4, 5, 6, 7))
#define PG8_MMA(ai, bj, At, Bt) do { __builtin_amdgcn_s_setprio(1); _Pragma("unroll") for (int m = 0; m < 4; ++m) _Pragma("unroll") for (int n = 0; n < 2; ++n) { \
        if constexpr (FP8) asm volatile("v_mfma_scale_f32_16x16x128_f8f6f4 %0, %1, %2, %0, %3, %4 op_sel_hi:[0,0,0]" : "+v"(acc[ai][bj][m][n]) : "v"(Bt[n]), "v"(At[m]), "v"(scb), "v"(sca)); \
        else { acc[ai][bj][m][n] = __builtin_amdgcn_mfma_f32_16x16x32_bf16(PG8_LO(Bt[n]), PG8_LO(At[m]), acc[ai][bj][m][n], 0, 0, 0); \
               acc[ai][bj][m][n] = __builtin_amdgcn_mfma_f32_16x16x32_bf16(PG8_HI(Bt[n]), PG8_HI(At[m]), acc[ai][bj][m][n], 0, 0, 0); } } \
        __builtin_amdgcn_s_setprio(0); } while (0)
#define PG8_WAIT_V(n) asm volatile("s_waitcnt vmcnt(" #n ")" ::: "memory")
#define PG8_WAIT_L(n) asm volatile("s_waitcnt lgkmcnt(" #n ")" ::: "memory")
#define PG8_BAR __builtin_amdgcn_s_barrier()
#define PG8_SCHED __builtin_amdgcn_sched_barrier(0)
    Unit cur, nxt; int ui = 0;
    if (!S.next(0, cur)) return;
    f32x4 acc[2][2][4][2];
#pragma unroll
    for (int a = 0; a < 2; ++a)
#pragma unroll
        for (int b = 0; b < 2; ++b)
#pragma unroll
            for (int m = 0; m < 4; ++m)
#pragma unroll
                for (int n = 0; n < 2; ++n) acc[a][b][m][n] = (f32x4){0.f, 0.f, 0.f, 0.f};
    v8i32 At[4], B0[2], B1[2];
    const int scb = SC_B * 0x01010101, sca = SC_A * 0x01010101;
    unsigned voffA0[2], voffA1[2], nvA0[2], nvA1[2];
#pragma unroll
    for (int i = 0; i < 2; ++i) {
        if constexpr (GATHER) { voffA0[i] = S.gather(cur, RA[i]) + (unsigned)CA[i] * 2u; voffA1[i] = S.gather(cur, RA[i] + HALF) + (unsigned)CA[i] * 2u; nvA0[i] = voffA0[i]; nvA1[i] = voffA1[i]; }
        else { voffA0[i] = (unsigned)(RA[i] * Kb + CA[i] * 2); }
    }
#define VA0 voffA0
#define VA1 (GATHER ? voffA1 : voffA0)
    const char* cA = S.a_base(cur); const char* cB = S.b_base(cur);
    if constexpr (SP2) {
        PG8_STAGE(PG8_SB(0, 0), cB, voffB); PG8_STAGE(PG8_SB(0, 1), cB + hstepB, voffB); PG8_STAGE(PG8_SA(0, 0), cA, voffA0); PG8_STAGE(PG8_SA(0, 1), cA + hstepA, VA1);
        if (wr == 1) PG8_BAR;
        PG8_WAIT_V(2); PG8_BAR;
        PG8_STAGE(PG8_SB(1, 0), cB + kstep, voffB); PG8_STAGE(PG8_SA(1, 0), cA + kstep, voffA0); PG8_STAGE(PG8_SB(1, 1), cB + hstepB + kstep, voffB);
        PG8_WAIT_V(6); PG8_BAR;
    } else {
        PG8_STAGE(PG8_SB(0, 0), cB, voffB); PG8_STAGE(PG8_SA(0, 0), cA, voffA0); PG8_STAGE(PG8_SB(0, 1), cB + hstepB, voffB); PG8_STAGE(PG8_SA(0, 1), cA + hstepA, VA1);
        if (wr == 1) PG8_BAR;
        PG8_WAIT_V(4); PG8_BAR;
        PG8_STAGE(PG8_SB(1, 0), cB + kstep, voffB); PG8_STAGE(PG8_SA(1, 0), cA + kstep, voffA0); PG8_STAGE(PG8_SB(1, 1), cB + hstepB + kstep, voffB);
        PG8_WAIT_V(6); PG8_BAR;
    }
    for (;;) {
        const bool has_next = S.next(ui + 1, nxt);
        const char* nA = has_next ? S.a_base(nxt) : cA; const char* nB = has_next ? S.b_base(nxt) : cB;
        if constexpr (GATHER) {
#pragma unroll
            for (int i = 0; i < 2; ++i) {
                if (has_next) { nvA0[i] = S.gather(nxt, RA[i]) + (unsigned)CA[i] * 2u; nvA1[i] = S.gather(nxt, RA[i] + HALF) + (unsigned)CA[i] * 2u; }
                else { nvA0[i] = voffA0[i]; nvA1[i] = voffA1[i]; }
            }
        }
#pragma unroll 1
        for (int t = 0; t < nt; t += 2) {
            if constexpr (HasMid<Epi>::v) { if (t == Epi::MID_T0 || t == Epi::MID_T1) {
                if constexpr (FP8) {
#pragma unroll
                    for (int a = 0; a < 2; ++a)
#pragma unroll
                        for (int b = 0; b < 2; ++b)
                            asm volatile("s_nop 15\n\ts_nop 15" : "+v"(acc[a][b][0][0]), "+v"(acc[a][b][0][1]), "+v"(acc[a][b][1][0]), "+v"(acc[a][b][1][1]), "+v"(acc[a][b][2][0]), "+v"(acc[a][b][2][1]), "+v"(acc[a][b][3][0]), "+v"(acc[a][b][3][1]));
                }
                E.mid(acc, cur, t == Epi::MID_T1 ? 1 : 0, wr, wc, fr, fq);
                if constexpr (FP8) {
#pragma unroll
                    for (int a = 0; a < 2; ++a)
#pragma unroll
                        for (int b = 0; b < 2; ++b)
                            asm volatile("s_nop 7" : "+v"(acc[a][b][0][0]), "+v"(acc[a][b][0][1]), "+v"(acc[a][b][1][0]), "+v"(acc[a][b][1][1]), "+v"(acc[a][b][2][0]), "+v"(acc[a][b][2][1]), "+v"(acc[a][b][3][0]), "+v"(acc[a][b][3][1]));
                } } }
            const bool last = (t == nt - 2);
            const char* a1 = cA + (size_t)(t + 1) * kstep;
            const char* a2 = last ? nA : cA + (size_t)(t + 2) * kstep; const char* b2 = last ? nB : cB + (size_t)(t + 2) * kstep;
            const char* a3 = a2 + kstep; const char* b3 = b2 + kstep;
            unsigned vA0[2], vA1[2];
#pragma unroll
            for (int i = 0; i < 2; ++i) { if constexpr (GATHER) { vA0[i] = last ? nvA0[i] : voffA0[i]; vA1[i] = last ? nvA1[i] : voffA1[i]; } else { vA0[i] = voffA0[i]; vA1[i] = voffA0[i]; } }
            if constexpr (SP2) {
            PG8_LDB(B0, 0, 0); PG8_LDB(B1, 0, 1); PG8_SCHED; PG8_LDA(At, 0, 0); PG8_STAGE(PG8_SA(1, 1), a1 + hstepA, VA1);
            PG8_WAIT_V(8); PG8_WAIT_L(0); PG8_BAR; PG8_MMA(0, 0, At, B0); PG8_MMA(0, 1, At, B1); PG8_BAR; PG8_SCHED;
            PG8_LDA(At, 0, 1); PG8_STAGE(PG8_SB(0, 0), b2, voffB); PG8_STAGE(PG8_SB(0, 1), b2 + hstepB, voffB); PG8_STAGE(PG8_SA(0, 0), a2, vA0);
            PG8_WAIT_V(8); PG8_WAIT_L(0); PG8_BAR; PG8_MMA(1, 0, At, B0); PG8_MMA(1, 1, At, B1); PG8_BAR; PG8_SCHED;
            PG8_LDB(B0, 1, 0); PG8_LDB(B1, 1, 1); PG8_SCHED; PG8_LDA(At, 1, 0); PG8_STAGE(PG8_SA(0, 1), a2 + hstepA, vA1);
            PG8_WAIT_V(8); PG8_WAIT_L(0); PG8_BAR; PG8_MMA(0, 0, At, B0); PG8_MMA(0, 1, At, B1); PG8_BAR; PG8_SCHED;
            PG8_LDA(At, 1, 1); PG8_STAGE(PG8_SB(1, 0), b3, voffB); PG8_STAGE(PG8_SB(1, 1), b3 + hstepB, voffB); PG8_STAGE(PG8_SA(1, 0), a3, vA0);
            PG8_WAIT_V(8); PG8_WAIT_L(0); PG8_BAR; PG8_MMA(1, 0, At, B0); PG8_MMA(1, 1, At, B1); PG8_BAR; PG8_SCHED;
            } else {
            PG8_LDB(B0, 0, 0); PG8_SCHED; PG8_LDA(At, 0, 0); PG8_STAGE(PG8_SA(1, 1), a1 + hstepA, VA1);
            PG8_WAIT_L(8); PG8_BAR; PG8_WAIT_L(0); PG8_MMA(0, 0, At, B0); PG8_BAR; PG8_SCHED;
            PG8_LDB(B1, 0, 1); PG8_STAGE(PG8_SB(0, 0), b2, voffB);
            PG8_BAR; PG8_WAIT_L(0); PG8_MMA(0, 1, At, B1); PG8_BAR;
            PG8_LDA(At, 0, 1); PG8_STAGE(PG8_SA(0, 0), a2, vA0);
            PG8_BAR; PG8_WAIT_L(0); PG8_MMA(1, 0, At, B0); PG8_BAR; PG8_SCHED;
            PG8_STAGE(PG8_SB(0, 1), b2 + hstepB, voffB);
            PG8_WAIT_V(6); PG8_BAR; PG8_MMA(1, 1, At, B1); PG8_BAR;
            PG8_LDB(B0, 1, 0); PG8_SCHED; PG8_LDA(At, 1, 0); PG8_STAGE(PG8_SA(0, 1), a2 + hstepA, vA1);
            PG8_WAIT_L(8); PG8_BAR; PG8_WAIT_L(0); PG8_MMA(0, 0, At, B0); PG8_BAR; PG8_SCHED;
            PG8_LDB(B1, 1, 1); PG8_STAGE(PG8_SB(1, 0), b3, voffB);
            PG8_BAR; PG8_WAIT_L(0); PG8_MMA(0, 1, At, B1); PG8_BAR;
            PG8_LDA(At, 1, 1); PG8_STAGE(PG8_SA(1, 0), a3, vA0);
            PG8_BAR; PG8_WAIT_L(0); PG8_MMA(1, 0, At, B0); PG8_BAR; PG8_SCHED;
            PG8_STAGE(PG8_SB(1, 1), b3 + hstepB, voffB);
            PG8_WAIT_V(6); PG8_BAR; PG8_MMA(1, 1, At, B1); PG8_BAR;
            }
        }
        if constexpr (ALIGN_EPI) { if (wr == 0) PG8_BAR; }
        if constexpr (FP8) {
#pragma unroll
            for (int a = 0; a < 2; ++a)
#pragma unroll
                for (int b = 0; b < 2; ++b)
                    asm volatile("s_nop 15\n\ts_nop 15" : "+v"(acc[a][b][0][0]), "+v"(acc[a][b][0][1]), "+v"(acc[a][b][1][0]), "+v"(acc[a][b][1][1]), "+v"(acc[a][b][2][0]), "+v"(acc[a][b][2][1]), "+v"(acc[a][b][3][0]), "+v"(acc[a][b][3][1]));
        }
        E(acc, cur, wr, wc, fr, fq);
        if (!has_next) break;
#pragma unroll
        for (int a = 0; a < 2; ++a)
#pragma unroll
            for (int b = 0; b < 2; ++b)
#pragma unroll
                for (int m = 0; m < 4; ++m)
#pragma unroll
                    for (int n = 0; n < 2; ++n) acc[a][b][m][n] = (f32x4){0.f, 0.f, 0.f, 0.f};
        cur = nxt; cA = nA; cB = nB; ++ui;
        if constexpr (GATHER) {
#pragma unroll
            for (int i = 0; i < 2; ++i) { voffA0[i] = nvA0[i]; voffA1[i] = nvA1[i]; } }
        if constexpr (ALIGN_EPI) { if (wr == 1) PG8_BAR; }
    }
    PG8_WAIT_V(0);
    if constexpr (!ALIGN_EPI) { if (wr == 0) PG8_BAR; }
    PG8_BAR;
#undef VA0
#undef VA1
#undef PG8_SA
#undef PG8_SB
#undef PG8_STAGE
#undef PG8_LD8
#undef PG8_LO
#undef PG8_HI
#undef PG8_LDA
#undef PG8_LDB
#undef PG8_MMA
#undef PG8_WAIT_V
#undef PG8_WAIT_L
#undef PG8_BAR
#undef PG8_SCHED
}

__device__ __forceinline__ float sigmoidf_fast(float x) { return __builtin_amdgcn_rcpf(1.0f + __builtin_amdgcn_exp2f(-x * LOG2E)); }

template <bool SIG> struct EpiProj {
    static constexpr bool PERM = true;
    bf16_t* O; int pn0; const float* rs;
    __device__ __forceinline__ void operator()(const f32x4 (&acc)[2][2][4][2], const Unit& u, int wr, int wc, int fr_in, int fq_in) const {
        int fr = fr_in, fq = fq_in; asm volatile("" : "+v"(fr), "+v"(fq));
        const int row0 = u.pm * BM + wr * 64 + fr, col0 = (pn0 + u.pn) * BM + wc * 64 + 8 * fq; constexpr bool sig = SIG;
#pragma unroll
        for (int ai = 0; ai < 2; ++ai)
#pragma unroll
            for (int m = 0; m < 4; ++m) { bf16_t* rowp = O + (size_t)(row0 + ai * HALF + m * 16) * PW + col0; const float rr = rs[row0 + ai * HALF + m * 16];
#pragma unroll
                for (int bj = 0; bj < 2; ++bj) { f32x4 v0 = acc[ai][bj][m][0] * rr, v1 = acc[ai][bj][m][1] * rr;
                    if (sig) {
#pragma unroll
                        for (int j = 0; j < 4; ++j) { v0[j] = sigmoidf_fast(v0[j]); v1[j] = sigmoidf_fast(v1[j]); } }
                    u32x4 w; w.x = cvt_pk_bf16(v0[0], v0[1]); w.y = cvt_pk_bf16(v0[2], v0[3]); w.z = cvt_pk_bf16(v1[0], v1[1]); w.w = cvt_pk_bf16(v1[2], v1[3]);
                    *(u32x4*)(rowp + bj * 32) = w; } }
    }
};
struct EpiGate8 {
    static constexpr bool PERM = true;
    unsigned char* g8;
    __device__ __forceinline__ void operator()(const f32x4 (&acc)[2][2][4][2], const Unit& u, int wr, int wc, int fr_in, int fq_in) const {
        int fr = fr_in, fq = fq_in; asm volatile("" : "+v"(fr), "+v"(fq));
        const int row0 = u.pm * BM + wr * 64 + fr, col0 = (u.pn & 7) * BM + wc * 64 + 8 * fq; const int br = u.pn >> 3; unsigned char* base = g8 + ((size_t)(br + (br >> 1)) << 26);
        constexpr float sc = -LOG2E;
#pragma unroll
        for (int ai = 0; ai < 2; ++ai)
#pragma unroll
            for (int m = 0; m < 4; ++m) { unsigned char* rowp = base + (size_t)(row0 + ai * HALF + m * 16) * D + col0;
#pragma unroll
                for (int bj = 0; bj < 2; ++bj) { const f32x4 v0 = acc[ai][bj][m][0] * sc, v1 = acc[ai][bj][m][1] * sc;
                    u32x2 w; w.x = pk4_fp8_c40(v0[0], v0[1], v0[2], v0[3]); w.y = pk4_fp8_c40(v1[0], v1[1], v1[2], v1[3]);
                    *(u32x2*)(rowp + bj * 32) = w; } }
    }
};
struct EpiUpH {
    static constexpr bool PERM = true, MID = true; static constexpr int MID_T0 = 4, MID_T1 = 12;
    const unsigned char* G; unsigned char* M8;
    __device__ __forceinline__ void mid(f32x4 (&acc)[2][2][4][2], const Unit& u, int which, int wr, int wc, int fr_in, int fq_in) const {
        int fr = fr_in, fq = fq_in; asm volatile("" : "+v"(fr), "+v"(fq));
        const int row0 = u.pm * BM + wr * 64 + fr, col0 = u.pn * BM + wc * 64 + 8 * fq;
        const unsigned char* G1 = G + (which ? ((size_t)1 << 26) : (size_t)0); const unsigned char* G2 = G + (which ? ((size_t)3 << 26) : ((size_t)1 << 26));
#pragma unroll
        for (int ai = 0; ai < 2; ++ai) {
            u32x2 g1[4][2], g2[4][2];
#pragma unroll
            for (int m = 0; m < 4; ++m)
#pragma unroll
                for (int bj = 0; bj < 2; ++bj) { const size_t off = (size_t)(row0 + ai * HALF + m * 16) * D + col0 + bj * 32;
                    g1[m][bj] = *(const u32x2*)(G1 + off); g2[m][bj] = *(const u32x2*)(G2 + off); }
            asm volatile("" ::: "memory");
#pragma unroll
            for (int m = 0; m < 4; ++m)
#pragma unroll
                for (int bj = 0; bj < 2; ++bj) { const u32x2 a = g1[m][bj], b = g2[m][bj];
#define RT(w1, w2, k) ((1.0f + __builtin_amdgcn_exp2f(__builtin_amdgcn_cvt_f32_fp8((int)(w2), k))) * __builtin_amdgcn_rcpf(1.0f + __builtin_amdgcn_exp2f(__builtin_amdgcn_cvt_f32_fp8((int)(w1), k))))
                    acc[ai][bj][m][0][0] *= RT(a.x, b.x, 0); acc[ai][bj][m][0][1] *= RT(a.x, b.x, 1); acc[ai][bj][m][0][2] *= RT(a.x, b.x, 2); acc[ai][bj][m][0][3] *= RT(a.x, b.x, 3);
                    acc[ai][bj][m][1][0] *= RT(a.y, b.y, 0); acc[ai][bj][m][1][1] *= RT(a.y, b.y, 1); acc[ai][bj][m][1][2] *= RT(a.y, b.y, 2); acc[ai][bj][m][1][3] *= RT(a.y, b.y, 3);
#undef RT
                }
            asm volatile("" ::: "memory");
        }
    }
    __device__ __forceinline__ void operator()(const f32x4 (&acc)[2][2][4][2], const Unit& u, int wr, int wc, int fr_in, int fq_in) const {
        int fr = fr_in, fq = fq_in; asm volatile("" : "+v"(fr), "+v"(fq));
        const int row0 = u.pm * BM + wr * 64 + fr, col0 = u.pn * BM + wc * 64 + 8 * fq;
        const unsigned char* G3 = G + ((size_t)3 << 26);
        constexpr float sc = (float)(1 << F8_HSH);
#pragma unroll
        for (int ai = 0; ai < 2; ++ai) {
            u32x2 g[4][2];
#pragma unroll
            for (int m = 0; m < 4; ++m)
#pragma unroll
                for (int bj = 0; bj < 2; ++bj) g[m][bj] = *(const u32x2*)(G3 + (size_t)(row0 + ai * HALF + m * 16) * D + col0 + bj * 32);
            asm volatile("" ::: "memory");
#pragma unroll
            for (int m = 0; m < 4; ++m)
#pragma unroll
                for (int bj = 0; bj < 2; ++bj) { const u32x2 gg = g[m][bj]; const f32x4 v0 = acc[ai][bj][m][0], v1 = acc[ai][bj][m][1];
#define SG(w, k) (sc * __builtin_amdgcn_rcpf(1.0f + __builtin_amdgcn_exp2f(__builtin_amdgcn_cvt_f32_fp8((int)(w), k))))
                    u32x2 w; w.x = pk4_fp8(v0[0] * SG(gg.x, 0), v0[1] * SG(gg.x, 1), v0[2] * SG(gg.x, 2), v0[3] * SG(gg.x, 3));
                    w.y = pk4_fp8(v1[0] * SG(gg.y, 0), v1[1] * SG(gg.y, 1), v1[2] * SG(gg.y, 2), v1[3] * SG(gg.y, 3));
#undef SG
                    *(u32x2*)(M8 + (size_t)(row0 + ai * HALF + m * 16) * D + col0 + bj * 32) = w; }
            asm volatile("" ::: "memory");
        }
    }
};
template <bool BASE_F32> struct EpiResid {
    static constexpr bool PERM = true; static constexpr int NSTORE = 16;
    const float* basef; bf16_t* X;
    __device__ __forceinline__ void operator()(const f32x4 (&acc)[2][2][4][2], const Unit& u, int wr, int wc, int fr_in, int fq_in) const {
        int fr = fr_in, fq = fq_in; asm volatile("" : "+v"(fr), "+v"(fq));
        const int row0 = u.pm * BM + wr * 64 + fr, col0 = u.pn * BM + wc * 64 + 8 * fq;
#pragma unroll
        for (int ai = 0; ai < 2; ++ai) {
            f32x4 b0[4][2], b1[4][2];
#pragma unroll
            for (int m = 0; m < 4; ++m)
#pragma unroll
                for (int bj = 0; bj < 2; ++bj) { const size_t off = (size_t)(row0 + ai * HALF + m * 16) * D + col0 + bj * 32;
                    if constexpr (BASE_F32) { b0[m][bj] = *(const f32x4*)(basef + off); b1[m][bj] = *(const f32x4*)(basef + off + 4); }
                    else { const u32x4 r = *(const u32x4*)(X + off); b0[m][bj] = (f32x4){bflo(r.x), bfhi(r.x), bflo(r.y), bfhi(r.y)}; b1[m][bj] = (f32x4){bflo(r.z), bfhi(r.z), bflo(r.w), bfhi(r.w)}; } }
            asm volatile("" ::: "memory");
#pragma unroll
            for (int m = 0; m < 4; ++m)
#pragma unroll
                for (int bj = 0; bj < 2; ++bj) { const size_t off = (size_t)(row0 + ai * HALF + m * 16) * D + col0 + bj * 32;
                    const f32x4 v0 = b0[m][bj] + acc[ai][bj][m][0], v1 = b1[m][bj] + acc[ai][bj][m][1];
                    u32x4 w; w.x = cvt_pk_bf16(v0[0], v0[1]); w.y = cvt_pk_bf16(v0[2], v0[3]); w.z = cvt_pk_bf16(v1[0], v1[1]); w.w = cvt_pk_bf16(v1[2], v1[3]);
                    *(u32x4*)(X + off) = w; }
            asm volatile("" ::: "memory");
        }
    }
};
struct EpiLogits {
    static constexpr bool PERM = false;
    float* L; const float* rs; float scale;
    __device__ __forceinline__ void operator()(const f32x4 (&acc)[2][2][4][2], const Unit& u, int wr, int wc, int fr_in, int fq_in) const {
        int fr = fr_in, fq = fq_in; asm volatile("" : "+v"(fr), "+v"(fq));
        if (wc >= 2) return;
        const int row0 = u.pm * BM + wr * 64 + fr, col0 = wc * 32 + 4 * fq; float* Lk = L + (size_t)u.pn * ((size_t)T * 64);
#pragma unroll
        for (int ai = 0; ai < 2; ++ai)
#pragma unroll
            for (int m = 0; m < 4; ++m) { float* rp = Lk + (size_t)(row0 + ai * HALF + m * 16) * 64 + col0; const float rr = rs[row0 + ai * HALF + m * 16];
#pragma unroll
                for (int n = 0; n < 2; ++n) *(f32x4*)(rp + n * 16) = acc[ai][0][m][n] * rr; }
    }
};
template <bool F8> struct EpiAct {
    static constexpr bool PERM = true;
    unsigned char* A;
    __device__ __forceinline__ void operator()(const f32x4 (&acc)[2][2][4][2], const Unit& u, int wr, int wc, int fr_in, int fq_in) const {
        int fr = fr_in, fq = fq_in; asm volatile("" : "+v"(fr), "+v"(fq));
        const int row0 = u.pm * BM + wr * 64 + fr, col0 = u.pn * HALF + wc * 32 + 8 * fq;
#pragma unroll
        for (int ai = 0; ai < 2; ++ai)
#pragma unroll
            for (int m = 0; m < 4; ++m) { float v[8];
#pragma unroll
                for (int n = 0; n < 2; ++n)
#pragma unroll
                    for (int j = 0; j < 4; ++j) { const float g = acc[ai][0][m][n][j], up = acc[ai][1][m][n][j]; v[4 * n + j] = g * sigmoidf_fast(g) * up; }
                if constexpr (F8) { constexpr float sc = (float)(1 << F8_ASH);
                    u32x2 w; w.x = pk4_fp8(v[0] * sc, v[1] * sc, v[2] * sc, v[3] * sc); w.y = pk4_fp8(v[4] * sc, v[5] * sc, v[6] * sc, v[7] * sc);
                    *(u32x2*)(A + (size_t)(row0 + ai * HALF + m * 16) * FF + col0) = w; }
                else { u32x4 w; w.x = cvt_pk_bf16(v[0], v[1]); w.y = cvt_pk_bf16(v[2], v[3]); w.z = cvt_pk_bf16(v[4], v[5]); w.w = cvt_pk_bf16(v[6], v[7]);
                    *(u32x4*)((bf16_t*)A + (size_t)(row0 + ai * HALF + m * 16) * FF + col0) = w; } }
    }
};
struct EpiDown {
    static constexpr bool PERM = true;
    unsigned char* Y; const float* slot_w;
    __device__ __forceinline__ void operator()(const f32x4 (&acc)[2][2][4][2], const Unit& u, int wr, int wc, int fr_in, int fq_in) const {
        int fr = fr_in, fq = fq_in; asm volatile("" : "+v"(fr), "+v"(fq));
        const int rl0 = wr * 64 + fr, col0 = u.pn * BM + wc * 64 + 8 * fq;
#pragma unroll
        for (int ai = 0; ai < 2; ++ai)
#pragma unroll
            for (int m = 0; m < 4; ++m) { const int rl = rl0 + ai * HALF + m * 16; const float w8 = (rl < u.nrow) ? slot_w[(size_t)u.e * CAP + (size_t)u.rank0 + rl] * (float)(1 << F8_YSH) : 0.f;
                unsigned char* rowp = Y + (size_t)(u.pm * BM + rl) * D + col0;
#pragma unroll
                for (int bj = 0; bj < 2; ++bj) { const f32x4 v0 = acc[ai][bj][m][0] * w8, v1 = acc[ai][bj][m][1] * w8;
                    u32x2 w; w.x = pk4_fp8(v0[0], v0[1], v0[2], v0[3]); w.y = pk4_fp8(v1[0], v1[1], v1[2], v1[3]);
                    *(u32x2*)(rowp + bj * 32) = w; } }
    }
};
}

#define XB_TMO      128
#define XB_XCNT(j)  (256  + 64 * (j))
#define XB_XSUB(j)  (1280 + 64 * (j))
#define XB_XGEN(j)  (2304 + 64 * (j))
#define XB_TOP      3328
#define XB_TOPGEN   3392
#define XCD_BAR_WORDS 3456
#define XB_SPIN_CAP (1u << 18)
__device__ __forceinline__ unsigned xb_ld(unsigned* p)              { return __hip_atomic_load(p, __ATOMIC_RELAXED, __HIP_MEMORY_SCOPE_AGENT); }
__device__ __forceinline__ unsigned xb_add(unsigned* p, unsigned v) { return __hip_atomic_fetch_add(p, v, __ATOMIC_RELAXED, __HIP_MEMORY_SCOPE_AGENT); }
__device__ __forceinline__ unsigned xb_xcc_id() { return (unsigned)__builtin_amdgcn_s_getreg((3 << 11) | 20) & 0xFu; }
#define XB_SPIN(cond, bar) do { unsigned _sp = 0; while (cond) { __builtin_amdgcn_s_sleep(1); \
    if ((++_sp & 255u) == 0u) { if (xb_ld(&(bar)[XB_TMO])) break; if (_sp > XB_SPIN_CAP) { atomicAdd(&(bar)[XB_TMO], 1u); break; } } } } while (0)
struct XcdBarrier { unsigned* bar; unsigned x; volatile LAS unsigned* st; };
__device__ __forceinline__ XcdBarrier xcd_barrier_post(unsigned* bar, volatile LAS unsigned* st) {
    XcdBarrier b; b.bar = bar; b.x = xb_xcc_id(); b.st = st;
    if (threadIdx.x == 0) (void)xb_add(&bar[XB_XCNT(b.x)], 1u);
    return b;
}
__device__ __forceinline__ void xcd_barrier_complete(unsigned* bar, unsigned x, unsigned& nloc, unsigned& nx) {
    const unsigned G = gridDim.x * gridDim.y * gridDim.z;
    unsigned sum, cnt, mine, sp = 0u;
    for (;;) {
        sum = 0u; cnt = 0u; mine = 0u;
#pragma unroll
        for (unsigned j = 0; j < 16; ++j) { const unsigned c = xb_ld(&bar[XB_XCNT(j)]); sum += c; cnt += (c > 0u) ? 1u : 0u; mine = (j == x) ? c : mine; }
        if (sum == G) break;
        __builtin_amdgcn_s_sleep(1);
        if ((++sp & 255u) == 0u) { if (xb_ld(&bar[XB_TMO])) break; if (sp > XB_SPIN_CAP) { atomicAdd(&bar[XB_TMO], 1u); break; } }
    }
    nloc = mine > 0u ? mine : 1u; nx = cnt > 0u ? cnt : 1u;
}
__device__ __forceinline__ void xcd_barrier(const XcdBarrier& b) {
    asm volatile("s_waitcnt vmcnt(0)" ::: "memory");
    __syncthreads();
    if (threadIdx.x == 0) {
        unsigned* bar = b.bar;
        __builtin_amdgcn_s_waitcnt(0);
        unsigned nloc = b.st[0], nx = b.st[1];
        if (nloc == 0u) { xcd_barrier_complete(bar, b.x, nloc, nx); b.st[0] = nloc; b.st[1] = nx; }
        const unsigned old = xb_add(&bar[XB_XSUB(b.x)], 1u);
        const unsigned gen = old / nloc;
        if (old + 1u == (gen + 1u) * nloc) {
            __builtin_amdgcn_fence(__ATOMIC_RELEASE, "agent");
            asm volatile("s_waitcnt vmcnt(0)" ::: "memory");
            const unsigned og = xb_add(&bar[XB_TOP], 1u);
            const unsigned tg = og / nx;
            if (og + 1u == (tg + 1u) * nx) xb_add(&bar[XB_TOPGEN], 1u);
            else XB_SPIN(xb_ld(&bar[XB_TOPGEN]) == tg, bar);
            __builtin_amdgcn_fence(__ATOMIC_ACQUIRE, "agent");
            xb_add(&bar[XB_XGEN(b.x)], 1u);
            asm volatile("s_waitcnt vmcnt(0)" ::: "memory");
        } else {
            XB_SPIN(xb_ld(&bar[XB_XGEN(b.x)]) == gen, bar);
            __builtin_amdgcn_fence(__ATOMIC_ACQUIRE, "agent");
            asm volatile("s_waitcnt vmcnt(0)" ::: "memory");
        }
    }
    __syncthreads();
}

struct Args { const float* in[20]; float* out; unsigned char* ws; float inv_freq[32]; int ph_lo, ph_hi; };
enum { I_X = 0, I_NORM_MIX, I_W_IN, I_POOL_W, I_POOL_SCALE, I_SWA_QN, I_SWA_KN, I_SWA_SINKS, I_MOBA_QN, I_MOBA_KN, I_W_UP_A, I_W_UP_B, I_W_UP_C, I_W_O, I_NORM_FFN,
       I_W_RG, I_W_RE, I_W_EG, I_W_EU, I_W_ED };

typedef const __attribute__((address_space(4))) Args* ArgsP;
struct Frame {
    LAS unsigned char* lds;
    gu32* ctl;
    unsigned char* ws;
    ArgsP ap;
    int tid, lane, wave, G, bid;
};
__device__ __forceinline__ float wave_sum(float v) {
#pragma unroll
    for (int o = 1; o < 64; o <<= 1) v += __shfl_xor(v, o);
    return v;
}

__device__ __forceinline__ void transpose_item(const float* W, int K, int N, bf16_t* WT, int kb, int nb, int rowbase, LAS float* scr, int lane, const float* kgain = nullptr, int dpitch = 0) {
    const int DP = dpitch ? dpitch : K;
    const int k0 = 64 * kb, n0 = 32 * nb;
#pragma unroll 8
    for (int i = 0; i < 32; ++i) { const int kk = 2 * i + (lane >> 5); const float gk = kgain ? kgain[k0 + kk] : 1.0f; scr[kk * 33 + (lane & 31)] = W[(size_t)(k0 + kk) * N + n0 + (lane & 31)] * gk; }
    LDS_WAIT(); asm volatile("" ::: "memory");
    const int c = lane & 7;
#pragma unroll
    for (int j = 0; j < 4; ++j) { const int n = (lane >> 3) + 8 * j; const LAS float* s = scr + (8 * c) * 33 + n;
        u32x4 o; o.x = pk2(s[0 * 33], s[1 * 33]); o.y = pk2(s[2 * 33], s[3 * 33]); o.z = pk2(s[4 * 33], s[5 * 33]); o.w = pk2(s[6 * 33], s[7 * 33]);
        *(GAS u32x4*)(WT + (size_t)(rowbase + n) * DP + k0 + 8 * c) = o; }
    LDS_WAIT(); asm volatile("" ::: "memory");
}
template <bool ILV>
__device__ __forceinline__ void transpose_item_fp8(const float* W, int K, int N, unsigned char* WT, int kb, int nb, int rowbase, LAS unsigned char* scr, int lane, int dpitch = 0) {
    const int DP = dpitch ? dpitch : K;
    const int k0 = 128 * kb, n0 = 64 * nb; constexpr float sc = (float)(1 << F8_WSH);
    const float* wp = W + (size_t)k0 * N + n0 + lane;
    float va[32], vb[32];
#define TLD(dst, b) do { _Pragma("unroll") for (int j = 0; j < 32; ++j) dst[j] = wp[(size_t)(32 * (b) + j) * N]; asm volatile("" ::: "memory"); } while (0)
#define TST(src, b) do { _Pragma("unroll") for (int j = 0; j < 8; ++j) *(LAS unsigned*)(scr + lane * 132 + 4 * (8 * (b) + j)) = pk4_fp8(src[4 * j] * sc, src[4 * j + 1] * sc, src[4 * j + 2] * sc, src[4 * j + 3] * sc); asm volatile("" ::: "memory"); } while (0)
    TLD(va, 0); TLD(vb, 1); TST(va, 0); TLD(va, 2); TST(vb, 1); TLD(vb, 3); TST(va, 2); TST(vb, 3);
#undef TLD
#undef TST
    LDS_WAIT(); asm volatile("" ::: "memory");
    const int c = lane & 7;
#pragma unroll
    for (int j = 0; j < 8; ++j) { const int nn = (lane >> 3) + 8 * j; const LAS unsigned* sp = (const LAS unsigned*)(scr + nn * 132 + 16 * c);
        u32x4 o; o.x = sp[0]; o.y = sp[1]; o.z = sp[2]; o.w = sp[3];
        const int row = rowbase + (ILV ? 64 * (nn >> 5) + (nn & 31) : nn);
        *(GAS u32x4*)(WT + (size_t)row * DP + k0 + 16 * c) = o; }
    LDS_WAIT(); asm volatile("" ::: "memory");
}
__device__ __forceinline__ void conv_phase(const Frame& F, int l) {
    const ArgsP a_ = F.ap;
#define a (*a_)
    LAS float* scr = (LAS float*)(F.lds + F.wave * 16384);
    unsigned char* ws = F.ws;
    const int gw = F.bid * NWAVES + F.wave, NGW = F.G * NWAVES;
    LAS unsigned char* scr8 = F.lds + F.wave * 16384;
    constexpr int I_INB = 32 * 104, I_IN8 = 16 * 96, I_UA = 4 * 32, I_UB = 8 * 32, I_UC = 4 * 32, I_O = 16 * 32, I_EG = 32 * 256, I_EU = 32 * 256, I_ED = 32 * 256;
    constexpr int NITEMS = I_INB + I_IN8 + I_UA + I_UB + I_UC + I_O + I_EG + I_EU + I_ED;
    static_assert(FP8_IN == 1 && FP8_MOE == 1 && FP8_O == 1, "conv_phase item lists are written for the fp8 build");
    for (int it = gw; it < NITEMS; it += NGW) {
        int r = it;
        if (r < I_EG + I_EU) {
            const int isup = r >= I_EG; if (isup) r -= I_EG;
            const int e = r >> 8, q = r & 255, kb = q >> 4, nb = q & 15, n0 = 64 * nb;
            const float* src = a.in[isup ? I_W_EU : I_W_EG] + ((size_t)l * NEXP + e) * (size_t)D * FF;
            transpose_item_fp8<true>(src, D, FF, ws + WS_W13 + (size_t)e * 2048 * D, kb, nb, 256 * (n0 >> 7) + 64 * ((n0 & 127) >> 5) + 32 * isup, scr8, F.lane); continue; }
        r -= I_EG + I_EU;
        if (r < I_ED) { const int e = r >> 8, q = r & 255, kb = q >> 5, nb = q & 31;
            transpose_item_fp8<false>(a.in[I_W_ED] + ((size_t)l * NEXP + e) * (size_t)FF * D, FF, D, ws + WS_WD + (size_t)e * 2048 * FF, kb, nb, 64 * nb, scr8, F.lane); continue; }
        r -= I_ED;
        if (r < I_IN8) { const int kb = r / 96, nb = r % 96;
            transpose_item_fp8<false>(a.in[I_W_IN] + (size_t)l * D * PW, D, PW, ws + WS_WIN8, kb, nb + 52, 64 * nb, scr8, F.lane); continue; }
        r -= I_IN8;
        if (r < I_INB) { const int kb = r / 104, nb = r % 104;
            transpose_item(a.in[I_W_IN] + (size_t)l * D * PW, D, PW, (bf16_t*)(ws + WS_WIN), kb, nb, 32 * nb, scr, F.lane, a.in[I_NORM_MIX] + (size_t)l * D); continue; }
        r -= I_INB;
        if (r < I_UA) { transpose_item_fp8<false>(a.in[I_W_UP_A] + (size_t)l * 512 * D, 512, D, ws + WS_WUPA, r / 32, r % 32, 64 * (r % 32), scr8, F.lane, D); continue; } r -= I_UA;
        if (r < I_UB) { transpose_item_fp8<false>(a.in[I_W_UP_B] + (size_t)l * 1024 * D, 1024, D, ws + WS_WUPA + 512, r / 32, r % 32, 64 * (r % 32), scr8, F.lane, D); continue; } r -= I_UB;
        if (r < I_UC) { transpose_item_fp8<false>(a.in[I_W_UP_C] + (size_t)l * 512 * D, 512, D, ws + WS_WUPA + 1536, r / 32, r % 32, 64 * (r % 32), scr8, F.lane, D); continue; } r -= I_UC;
        transpose_item_fp8<false>(a.in[I_W_O] + (size_t)l * D * D, D, D, ws + WS_WO, r / 32, r % 32, 64 * (r % 32), scr8, F.lane);
    }
    const int gt = F.bid * NTHR + F.tid, NGT = F.G * NTHR;
    { bf16_t* wr = (bf16_t*)(ws + WS_WR); const float* wg = a.in[I_W_RG] + (size_t)l * D * 4; const float* we = a.in[I_W_RE] + (size_t)l * D * 32;
      const float* gf = a.in[I_NORM_FFN] + (size_t)l * D;
      for (int i = gt; i < 256 * D; i += NGT) { const int n = i >> 11, k = i & 2047; const float v = n < 4 ? wg[k * 4 + n] : (n < 36 ? we[k * 32 + (n - 4)] : 0.f); wr[i] = (bf16_t)f2bf(v * gf[k]); } }
    { bf16_t* pw = (bf16_t*)(ws + WS_POOLW); const float* src = a.in[I_POOL_W] + (size_t)l * 4 * 128 * 128;
      for (int i = gt; i < 4 * 128 * 128; i += NGT) { const int g = i >> 14, e = (i >> 7) & 127, c = i & 127; pw[i] = (bf16_t)f2bf(src[(g * 128 + c) * 128 + e]); } }
    if (l == 0) {
        f32x2* rt = (f32x2*)(ws + WS_ROPE);
        for (int i = gt; i < SEQ * 32; i += NGT) {
            const int pos = i >> 5, fi = i & 31; const float ang = (float)pos * a.inv_freq[fi];
            const double x = (double)ang; const double kq = __builtin_rint(x * 0.63661977236758134308);
            double r = __builtin_fma(-kq, 1.57079632679489655800e+00, x); r = __builtin_fma(-kq, 6.12323399573676603587e-17, r);
            const double r2 = r * r;
            double s = -1.0 / 1307674368000.0; s = s * r2 + 1.0 / 6227020800.0; s = s * r2 - 1.0 / 39916800.0; s = s * r2 + 1.0 / 362880.0; s = s * r2 - 1.0 / 5040.0; s = s * r2 + 1.0 / 120.0; s = s * r2 - 1.0 / 6.0; s = s * r2 * r + r;
            double c = 1.0 / 20922789888000.0; c = c * r2 - 1.0 / 87178291200.0; c = c * r2 + 1.0 / 479001600.0; c = c * r2 - 1.0 / 3628800.0; c = c * r2 + 1.0 / 40320.0; c = c * r2 - 1.0 / 720.0; c = c * r2 + 1.0 / 24.0; c = c * r2 - 0.5; c = c * r2 + 1.0;
            const int qd = (int)((long long)kq & 3);
            const double sn = (qd == 0) ? s : (qd == 1) ? c : (qd == 2) ? -s : -c;
            const double cs = (qd == 0) ? c : (qd == 1) ? -s : (qd == 2) ? -c : s;
            rt[i] = (f32x2){(float)cs, (float)sn};
        }
    }
#undef a
}

__device__ __forceinline__ void build_blkbase(const Frame& F, const gu32* cnt) {
    LAS int* bb = (LAS int*)(F.lds + MISC_OFF + 256);
    __syncthreads();
    if (F.tid < 33) { int s = 0; for (int e = 0; e < F.tid; ++e) s += (int)((__hip_atomic_load(cnt + e, RLX_AGENT) + 255u) >> 8); bb[F.tid] = s; }
    __syncthreads();
}
template <int MODE>
__device__ __forceinline__ void norm_phase(const Frame& F, const float* src, float* out, const float* gain, const gu32* cnt_prev) {
    const int gw = F.bid * NWAVES + F.wave, NGW = F.G * NWAVES;
    const LAS int* bb = (const LAS int*)(F.lds + MISC_OFF + 256);
    if (MODE >= 2) build_blkbase(F, cnt_prev);
    unsigned char* H8 = F.ws + WS_H8; float* RS = (float*)(F.ws + (MODE == 1 ? WS_RS2 : WS_RS1));
    bf16_t* X = (bf16_t*)(F.ws + WS_X);
    const unsigned char* Y = F.ws + WS_Y;
    const int* tokr = (const int*)(F.ws + WS_TOKR);
    f32x4 g[8];
    if (MODE != 3) {
#pragma unroll
        for (int j = 0; j < 8; ++j) g[j] = *(const f32x4*)(gain + 4 * F.lane + 256 * j);
    }
    for (int m = gw; m < T; m += NGW) {
        f32x4 v[8];
        if (MODE == 0) { const float* xr = src + (size_t)m * D + 4 * F.lane; bf16_t* xw = X + (size_t)m * D + 4 * F.lane;
#pragma unroll
            for (int j = 0; j < 8; ++j) { const f32x4 t4 = *(const f32x4*)(xr + 256 * j); u32x2 w; w.x = cvt_pk_bf16(t4[0], t4[1]); w.y = cvt_pk_bf16(t4[2], t4[3]); *(u32x2*)(xw + 256 * j) = w;
                v[j] = (f32x4){bflo(w.x), bfhi(w.x), bflo(w.y), bfhi(w.y)}; } }
        else { const bf16_t* xr = X + (size_t)m * D + 4 * F.lane;
#pragma unroll
            for (int j = 0; j < 8; ++j) { const u32x2 r = *(const u32x2*)(xr + 256 * j); v[j] = (f32x4){bflo(r.x), bfhi(r.x), bflo(r.y), bfhi(r.y)}; } }
        if (MODE >= 2) {
            const int e0 = tokr[m * 4 + 0], r0 = tokr[m * 4 + 1], e1 = tokr[m * 4 + 2], r1 = tokr[m * 4 + 3];
            const unsigned char* y0 = Y + ((size_t)bb[e0] * 256 + r0) * D + 4 * F.lane; const unsigned char* y1 = Y + ((size_t)bb[e1] * 256 + r1) * D + 4 * F.lane;
            constexpr float ysc = 1.0f / (float)(1 << F8_YSH);
#pragma unroll
            for (int j = 0; j < 8; ++j) { const int a = *(const int*)(y0 + 256 * j), b = *(const int*)(y1 + 256 * j);
                v[j][0] += (__builtin_amdgcn_cvt_f32_fp8(a, 0) + __builtin_amdgcn_cvt_f32_fp8(b, 0)) * ysc; v[j][1] += (__builtin_amdgcn_cvt_f32_fp8(a, 1) + __builtin_amdgcn_cvt_f32_fp8(b, 1)) * ysc;
                v[j][2] += (__builtin_amdgcn_cvt_f32_fp8(a, 2) + __builtin_amdgcn_cvt_f32_fp8(b, 2)) * ysc; v[j][3] += (__builtin_amdgcn_cvt_f32_fp8(a, 3) + __builtin_amdgcn_cvt_f32_fp8(b, 3)) * ysc; }
            if (MODE == 3) { float* orow = out + (size_t)m * D + 4 * F.lane;
#pragma unroll
                for (int j = 0; j < 8; ++j) *(f32x4*)(orow + 256 * j) = v[j]; }
            else { bf16_t* xw = X + (size_t)m * D + 4 * F.lane;
#pragma unroll
                for (int j = 0; j < 8; ++j) { u32x2 w; w.x = cvt_pk_bf16(v[j][0], v[j][1]); w.y = cvt_pk_bf16(v[j][2], v[j][3]); *(u32x2*)(xw + 256 * j) = w;
                    v[j] = (f32x4){bflo(w.x), bfhi(w.x), bflo(w.y), bfhi(w.y)}; } }
        }
        if (MODE != 3) {
            float s = 0.f;
#pragma unroll
            for (int j = 0; j < 8; ++j) s += (v[j][0] * v[j][0] + v[j][1] * v[j][1]) + (v[j][2] * v[j][2] + v[j][3] * v[j][3]);
            const float rstd = 1.0f / sqrtf(wave_sum(s) * (1.0f / D) + RMS_EPS);
            if (F.lane == 0) RS[m] = rstd;
#pragma unroll
            for (int j = 0; j < 8; ++j) { const float h0 = v[j][0] * rstd * g[j][0], h1 = v[j][1] * rstd * g[j][1], h2 = v[j][2] * rstd * g[j][2], h3 = v[j][3] * rstd * g[j][3];
                constexpr float sc = (float)(1 << F8_HSH);
                *(unsigned*)(H8 + (size_t)m * D + 4 * F.lane + 256 * j) = pk4_fp8(h0 * sc, h1 * sc, h2 * sc, h3 * sc); }
        }
    }
}

__device__ __forceinline__ void qk_norm_rope8(bf16_t* p, const u32x4 raw, const float (&g8)[8], const f32x4 (&cs)[4], int s, float (&y)[8]) {
    float v[8] = {bflo(raw.x), bfhi(raw.x), bflo(raw.y), bfhi(raw.y), bflo(raw.z), bfhi(raw.z), bflo(raw.w), bfhi(raw.w)};
    float ss = 0.f;
#pragma unroll
    for (int i = 0; i < 8; ++i) ss += v[i] * v[i];
    ss += __shfl_xor(ss, 1); ss += __shfl_xor(ss, 2); ss += __shfl_xor(ss, 4);
    const float rstd = 1.0f / sqrtf(ss * (1.0f / 64.0f) + RMS_EPS);
    const float sgn = (s < 4) ? -1.f : 1.f;
#pragma unroll
    for (int i = 0; i < 8; ++i) v[i] = v[i] * rstd * g8[i];
#pragma unroll
    for (int i2 = 0; i2 < 4; ++i2) {
        const float p0 = __shfl_xor(v[2 * i2], 4), p1 = __shfl_xor(v[2 * i2 + 1], 4);
        y[2 * i2] = v[2 * i2] * cs[i2][0] + sgn * p0 * cs[i2][1]; y[2 * i2 + 1] = v[2 * i2 + 1] * cs[i2][2] + sgn * p1 * cs[i2][3]; }
    u32x4 o; o.x = pk2(y[0], y[1]); o.y = pk2(y[2], y[3]); o.z = pk2(y[4], y[5]); o.w = pk2(y[6], y[7]);
    *(u32x4*)p = o;
}
__device__ __forceinline__ void prep_phase(const Frame& F, int l) {
    const ArgsP a_ = F.ap;
#define a (*a_)
    bf16_t* PROJ = (bf16_t*)(F.ws + WS_PROJ);
    const f32x2* rope = (const f32x2*)(F.ws + WS_ROPE);
    float* KMP = (float*)(F.ws + WS_KMP);
    unsigned char* YA = F.ws + WS_YA;
    const bf16_t* POOLW = (const bf16_t*)(F.ws + WS_POOLW);
    const float* pscale = a.in[I_POOL_SCALE] + (size_t)l * 512;
    LAS bf16_t* PT = (LAS bf16_t*)F.lds;
    const int grp = F.tid >> 3, s = F.tid & 7;
    for (int unit = F.bid; unit < T / 128; unit += F.G) {
        const int b = unit >> 7, t0 = (unit & 127) * 128; const size_t tb = (size_t)b * SEQ + t0;
        {
            f32x4 cs[2][4];
#pragma unroll
            for (int it = 0; it < 2; ++it) { const f32x4* rr = (const f32x4*)(rope + (size_t)(t0 + grp + 64 * it) * 32 + 8 * (s & 3));
#pragma unroll
                for (int i2 = 0; i2 < 4; ++i2) cs[it][i2] = rr[i2]; }
            const float* gq = a.in[I_SWA_QN] + (size_t)l * 64 + 8 * s; const float* gk = a.in[I_SWA_KN] + (size_t)l * 64 + 8 * s; const float* gm = a.in[I_MOBA_QN] + (size_t)l * 64 + 8 * s;
            float g8q[8], g8k[8], g8m[8];
#pragma unroll
            for (int i = 0; i < 8; ++i) { g8q[i] = gq[i]; g8k[i] = gk[i]; g8m[i] = gm[i]; }
#pragma unroll 1
            for (int h0 = 0; h0 < 28; h0 += 7) {
                u32x4 raw[7][2]; bf16_t* ptr[7][2];
#pragma unroll
                for (int k = 0; k < 7; ++k) { const int hs = h0 + k;
                    const int col = hs < 16 ? QB_OFF + 64 * hs : (hs < 18 ? KB_OFF + 64 * (hs - 16) : QM_OFF + 64 * (hs - 18));
#pragma unroll
                    for (int it = 0; it < 2; ++it) { ptr[k][it] = PROJ + (tb + grp + 64 * it) * PW + col + 8 * s; if (hs < 26) raw[k][it] = *(const u32x4*)ptr[k][it]; } }
                asm volatile("" ::: "memory");
#pragma unroll
                for (int k = 0; k < 7; ++k) { const int hs = h0 + k;
                    if (hs < 26) {
#pragma unroll
                        for (int it = 0; it < 2; ++it) { float y[8];
                            if (hs < 16) qk_norm_rope8(ptr[k][it], raw[k][it], g8q, cs[it], s, y); else if (hs < 18) qk_norm_rope8(ptr[k][it], raw[k][it], g8k, cs[it], s, y); else qk_norm_rope8(ptr[k][it], raw[k][it], g8m, cs[it], s, y); } } }
            }
        }
        {
            const int h = F.wave, gi = F.lane >> 3;
            const float* gp = a.in[I_MOBA_KN] + (size_t)l * 64 + 8 * s;
            float g8[8], acc8[8];
#pragma unroll
            for (int i = 0; i < 8; ++i) { g8[i] = gp[i]; acc8[i] = 0.f; }
#pragma unroll 1
            for (int it0 = 0; it0 < 16; it0 += 4) {
                u32x4 raw[4]; f32x4 cs[4][4]; bf16_t* ptr[4];
#pragma unroll
                for (int k = 0; k < 4; ++k) { const int tok = gi + 8 * (it0 + k); ptr[k] = PROJ + (tb + tok) * PW + KM_OFF + 64 * h + 8 * s; raw[k] = *(const u32x4*)ptr[k];
                    const f32x4* rr = (const f32x4*)(rope + (size_t)(t0 + tok) * 32 + 8 * (s & 3));
#pragma unroll
                    for (int i2 = 0; i2 < 4; ++i2) cs[k][i2] = rr[i2]; }
                asm volatile("" ::: "memory");
#pragma unroll
                for (int k = 0; k < 4; ++k) { float y[8]; qk_norm_rope8(ptr[k], raw[k], g8, cs[k], s, y);
#pragma unroll
                    for (int i = 0; i < 8; ++i) acc8[i] += y[i]; }
            }
#pragma unroll
            for (int i = 0; i < 8; ++i) { acc8[i] += __shfl_xor(acc8[i], 8); acc8[i] += __shfl_xor(acc8[i], 16); acc8[i] += __shfl_xor(acc8[i], 32); }
            if (gi == 0) { float* kp = KMP + ((size_t)(b * 128 + (t0 >> 7)) * 8 + h) * 64 + 8 * s;
#pragma unroll
                for (int i = 0; i < 8; ++i) kp[i] = acc8[i]; }
        }
#pragma unroll 1
        for (int g = 0; g < 4; ++g) {
            const int w = 2 << g;
            __syncthreads();
#pragma unroll
            for (int k = 0; k < 4; ++k) {
                const int idx = F.tid + NTHR * k, tok = idx >> 4, ch = idx & 15; const int pos = t0 + tok; const int cnt = (pos + 1 < w) ? pos + 1 : w;
                const bf16_t* xp = PROJ + (tb + tok) * PW + XA_OFF + 128 * g + 8 * ch;
                float sum[8], x0[8];
#pragma unroll
                for (int i = 0; i < 8; ++i) sum[i] = 0.f;
#pragma unroll 2
                for (int i = 0; i < w; i += 2) {
                    u32x4 r0 = {0u, 0u, 0u, 0u}, r1 = {0u, 0u, 0u, 0u};
                    if (i < cnt) r0 = *(const u32x4*)(xp - (size_t)i * PW);
                    if (i + 1 < cnt) r1 = *(const u32x4*)(xp - (size_t)(i + 1) * PW);
                    const float v0[8] = {bflo(r0.x), bfhi(r0.x), bflo(r0.y), bfhi(r0.y), bflo(r0.z), bfhi(r0.z), bflo(r0.w), bfhi(r0.w)};
                    const float v1[8] = {bflo(r1.x), bfhi(r1.x), bflo(r1.y), bfhi(r1.y), bflo(r1.z), bfhi(r1.z), bflo(r1.w), bfhi(r1.w)};
#pragma unroll
                    for (int q = 0; q < 8; ++q) { sum[q] += v0[q] + v1[q]; if (i == 0) x0[q] = v0[q]; }
                }
                const float rc = 1.0f / (float)cnt;
                u32x4 o; o.x = pk2(sum[0] * rc - x0[0], sum[1] * rc - x0[1]); o.y = pk2(sum[2] * rc - x0[2], sum[3] * rc - x0[3]);
                o.z = pk2(sum[4] * rc - x0[4], sum[5] * rc - x0[5]); o.w = pk2(sum[6] * rc - x0[6], sum[7] * rc - x0[7]);
                *(LAS u32x4*)(PT + tok * 136 + 8 * ch) = o;
            }
            __syncthreads();
            const int r16 = F.lane & 15, kg = F.lane >> 4;
            bf16x8 af[4];
#pragma unroll
            for (int ks = 0; ks < 4; ++ks) af[ks] = *(const LAS bf16x8*)(PT + (16 * F.wave + r16) * 136 + 32 * ks + 8 * kg);
#pragma unroll
            for (int nt = 0; nt < 8; ++nt) {
                f32x4 acc = {0.f, 0.f, 0.f, 0.f};
#pragma unroll
                for (int ks = 0; ks < 4; ++ks) { const bf16x8 bfr = *(const bf16x8*)(POOLW + ((size_t)g * 128 + 16 * nt + r16) * 128 + 32 * ks + 8 * kg);
                    acc = __builtin_amdgcn_mfma_f32_16x16x32_bf16(bfr, af[ks], acc, 0, 0, 0); }
                const int e0 = 128 * g + 16 * nt + 4 * kg; const f32x4 sc = *(const f32x4*)(pscale + e0);
                constexpr float ms = (float)(1 << F8_MSH);
                *(unsigned*)(YA + (tb + 16 * F.wave + r16) * 2048 + e0) = pk4_fp8(acc[0] * sc[0] * ms, acc[1] * sc[1] * ms, acc[2] * sc[2] * ms, acc[3] * sc[3] * ms);
            }
        }
        __syncthreads();
    }
#undef a
}

typedef short v4i16_t __attribute__((ext_vector_type(4)));
__device__ __forceinline__ s16x4 vtr(const LAS unsigned char* p) { return __builtin_bit_cast(s16x4, __builtin_amdgcn_ds_read_tr16_b64_v4i16((LAS v4i16_t*)p)); }
__device__ __forceinline__ void load_kv256(LAS unsigned char* kb, LAS unsigned char* vb, const bf16_t* ksrc, const bf16_t* vsrc, int tid, int zero_rows) {
#pragma unroll
    for (int it = 0; it < 4; ++it) {
        const int i = tid + NTHR * it, key = i >> 3, c = i & 7;
        u32x4 kv = {0u, 0u, 0u, 0u}, vv = {0u, 0u, 0u, 0u};
        if (key >= zero_rows) { kv = *(const u32x4*)(ksrc + (size_t)key * PW + 8 * c); vv = *(const u32x4*)(vsrc + (size_t)key * PW + 8 * c); }
        *(LAS u32x4*)(kb + c * 4096 + ((key ^ c) << 4)) = kv;
        *(LAS u32x4*)(vb + (c >> 2) * 16384 + key * 64 + (c & 3) * 16) = vv;
    }
}
__device__ __forceinline__ float score_bound(const float* gq, const float* gk, int lane) {
    float a = fabsf(gq[lane]), b = fabsf(gk[lane]);
#pragma unroll
    for (int o = 1; o < 64; o <<= 1) { a = fmaxf(a, __shfl_xor(a, o)); b = fmaxf(b, __shfl_xor(b, o)); }
    return 64.0f * C2 * 1.02f * a * b;
}
template <int NT, int MASK>
__device__ __forceinline__ void attn_step(const LAS unsigned char* kb, const LAS unsigned char* vb, const int kt0, const bf16x8 (&q)[4], f32x16 (&o)[2], float& m, float& l,
                                          const int lane, const int qt, const bool blk0) {
    const int r32 = lane & 31, hi = lane >> 5;
    f32x16 p[NT];
#pragma unroll
    for (int i = 0; i < NT; ++i)
#pragma unroll
        for (int r = 0; r < 16; ++r) p[i][r] = 0.f;
#pragma unroll
    for (int s = 0; s < 4; ++s)
#pragma unroll
        for (int i = 0; i < NT; ++i) { const int key = 32 * (kt0 + i) + r32, ch = 2 * s + hi;
            const bf16x8 kf = *(const LAS bf16x8*)(kb + ch * 4096 + ((key ^ ch) << 4));
            p[i] = __builtin_amdgcn_mfma_f32_32x32x16_bf16(kf, q[s], p[i], 0, 0, 0); }
    const int qw = 32 * qt + r32;
    if (MASK != 0) {
#pragma unroll
        for (int i = 0; i < NT; ++i)
#pragma unroll
            for (int r = 0; r < 16; ++r) { const int kw = 32 * (kt0 + i) + (r & 3) + 8 * (r >> 2) + 4 * hi;
                const bool ok = (MASK == 1) ? (kw > qw && kw <= qw + 128 && (!blk0 || kw >= 128)) : (kw <= qw);
                p[i][r] = ok ? p[i][r] : -INFINITY; }
    }
    const float nm = -m;
    float ps = 0.f;
#pragma unroll
    for (int i = 0; i < NT; ++i)
#pragma unroll
        for (int r = 0; r < 16; ++r) { const float e = __builtin_amdgcn_exp2f(__builtin_fmaf(p[i][r], C2, nm)); p[i][r] = e; ps += e; }
    l += ps;
    const int vlane = (4 * hi + ((lane & 15) >> 2)) * 64 + ((lane >> 4) & 1) * 32 + (lane & 3) * 8;
#pragma unroll
    for (int i = 0; i < NT; ++i) {
        u32x4 pw[2];
#pragma unroll
        for (int s2 = 0; s2 < 2; ++s2) { pw[s2].x = cvt_pk_bf16(p[i][8 * s2 + 0], p[i][8 * s2 + 1]); pw[s2].y = cvt_pk_bf16(p[i][8 * s2 + 2], p[i][8 * s2 + 3]);
            pw[s2].z = cvt_pk_bf16(p[i][8 * s2 + 4], p[i][8 * s2 + 5]); pw[s2].w = cvt_pk_bf16(p[i][8 * s2 + 6], p[i][8 * s2 + 7]); }
#pragma unroll
        for (int s2 = 0; s2 < 2; ++s2)
#pragma unroll
            for (int d0 = 0; d0 < 2; ++d0) {
                const LAS unsigned char* vp = vb + d0 * 16384 + (32 * (kt0 + i) + 16 * s2) * 64 + vlane;
                const s16x4 lo = vtr(vp), hi4 = vtr(vp + 512);
                const bf16x8 vf = {lo[0], lo[1], lo[2], lo[3], hi4[0], hi4[1], hi4[2], hi4[3]};
                o[d0] = __builtin_amdgcn_mfma_f32_32x32x16_bf16(vf, __builtin_bit_cast(bf16x8, pw[s2]), o[d0], 0, 0, 0); }
    }
}

#define SELIDX(t, h) ((((size_t)(t) >> 14) * 8 + (size_t)(h)) * SEQ + ((size_t)(t) & (SEQ - 1)))
__device__ __forceinline__ void gate_unit(const Frame& F, int b, int j, int hp) {
    const bf16_t* PROJ = (const bf16_t*)(F.ws + WS_PROJ);
    const float* KMP = (const float*)(F.ws + WS_KMP);
    unsigned* SEL = (unsigned*)(F.ws + WS_SEL);
    LAS unsigned char* km = F.lds;
    __syncthreads();
    for (int i = F.tid; i < j * 128; i += NTHR) { const int n = i >> 7, rem = i & 127, hh = rem >> 6, d = rem & 63, h2 = hp * 2 + hh;
        const float v = (KMP[((size_t)(b * 128 + 2 * n) * 8 + h2) * 64 + d] + KMP[((size_t)(b * 128 + 2 * n + 1) * 8 + h2) * 64 + d]) * (1.0f / 256.0f);
        const unsigned vh = f2bf(v); const float rest = v - __builtin_bit_cast(float, vh << 16);
        LAS bf16_t* p = (LAS bf16_t*)(km + hh * 16384 + (d >> 3) * 1024 + n * 16 + (d & 7) * 2);
        p[0] = (bf16_t)vh; p[4096] = (bf16_t)f2bf(rest); }
    __syncthreads();
    const int lane = F.lane, r32 = lane & 31, hi = lane >> 5, hh = F.wave >> 2, h = hp * 2 + hh;
    const LAS unsigned char* kmh = km + hh * 16384;
    const int ngrp = (j + 31) >> 5;
#pragma unroll 1
    for (int tile = 0; tile < 2; ++tile) {
        const size_t t = (size_t)b * SEQ + 256 * j + (F.wave & 3) * 64 + 32 * tile + r32;
        bf16x8 q[4];
#pragma unroll
        for (int s = 0; s < 4; ++s) q[s] = *(const bf16x8*)(PROJ + t * PW + QM_OFF + 64 * h + 16 * s + 8 * hi);
        float v0 = -INFINITY, v1 = -INFINITY, v2 = -INFINITY; unsigned i0 = 255u, i1 = 255u, i2 = 255u;
#pragma unroll 1
        for (int g = 0; g < ngrp; ++g) {
            f32x16 p;
#pragma unroll
            for (int r = 0; r < 16; ++r) p[r] = 0.f;
#pragma unroll
            for (int s = 0; s < 4; ++s)
#pragma unroll
                for (int part = 0; part < 2; ++part) { const bf16x8 kf = *(const LAS bf16x8*)(kmh + part * 8192 + (2 * s + hi) * 1024 + ((32 * g + r32) << 4));
                    p = __builtin_amdgcn_mfma_f32_32x32x16_bf16(kf, q[s], p, 0, 0, 0); }
#pragma unroll
            for (int r = 0; r < 16; ++r) { const int n = 32 * g + (r & 3) + 8 * (r >> 2) + 4 * hi;
                const float dv = (n < j) ? p[r] : -INFINITY;
                if (dv > v0) { v2 = v1; i2 = i1; v1 = v0; i1 = i0; v0 = dv; i0 = (unsigned)n; }
                else if (dv > v1) { v2 = v1; i2 = i1; v1 = dv; i1 = (unsigned)n; }
                else if (dv > v2) { v2 = dv; i2 = (unsigned)n; } }
        }
        const float w0 = __shfl_xor(v0, 32), w1 = __shfl_xor(v1, 32), w2 = __shfl_xor(v2, 32);
        const unsigned k0 = __shfl_xor(i0, 32), k1 = __shfl_xor(i1, 32), k2 = __shfl_xor(i2, 32);
#define GINS(dv, n) do { const float dv_ = (dv); const unsigned n_ = (n); \
            if (dv_ > v0 || (dv_ == v0 && n_ < i0)) { v2 = v1; i2 = i1; v1 = v0; i1 = i0; v0 = dv_; i0 = n_; } \
            else if (dv_ > v1 || (dv_ == v1 && n_ < i1)) { v2 = v1; i2 = i1; v1 = dv_; i1 = n_; } \
            else if (dv_ > v2 || (dv_ == v2 && n_ < i2)) { v2 = dv_; i2 = n_; } } while (0)
        GINS(w0, k0); GINS(w1, k1); GINS(w2, k2);
#undef GINS
        if (hi == 0) SEL[SELIDX(t, h)] = i0 | (i1 << 8) | (i2 << 16) | 0xFF000000u;
    }
}
__device__ __forceinline__ void swa_unit(const Frame& F, int l, int b, int g, int blk) {
    const bf16_t* PROJ = (const bf16_t*)(F.ws + WS_PROJ);
    unsigned char* YB = F.ws + WS_YA + 512;
    LAS unsigned char* kb = F.lds; LAS unsigned char* vb = F.lds + 32768;
    const size_t tb = (size_t)b * SEQ + (size_t)blk * 128;
    __syncthreads();
    { const long long w0 = (long long)tb - 128;
      load_kv256(kb, vb, PROJ + w0 * PW + KB_OFF + 64 * g, PROJ + w0 * PW + VB_OFF + 64 * g, F.tid, blk == 0 ? 128 : 0); }
    __syncthreads();
    const int head = g * 8 + F.wave, lane = F.lane, r32 = lane & 31, hi = lane >> 5;
    const float sink2 = F.ap->in[I_SWA_SINKS][l * 16 + head] * LOG2E;
    const float sbound = score_bound(F.ap->in[I_SWA_QN] + (size_t)l * 64, F.ap->in[I_SWA_KN] + (size_t)l * 64, lane);
    for (int qt = 0; qt < 4; ++qt) {
        const size_t tq = tb + 32 * qt + r32;
        bf16x8 q[4];
#pragma unroll
        for (int s = 0; s < 4; ++s) q[s] = *(const bf16x8*)(PROJ + tq * PW + QB_OFF + 64 * head + 16 * s + 8 * hi);
        f32x16 o[2];
#pragma unroll
        for (int r = 0; r < 16; ++r) { o[0][r] = 0.f; o[1][r] = 0.f; }
        float m = fmaxf(sbound, sink2), lsum = (hi == 0) ? __builtin_amdgcn_exp2f(sink2 - m) : 0.0f;
        if (blk == 0) {
            attn_step<2, 1>(kb, vb, qt, q, o, m, lsum, lane, qt, true);
            attn_step<2, 1>(kb, vb, qt + 2, q, o, m, lsum, lane, qt, true);
            attn_step<1, 1>(kb, vb, qt + 4, q, o, m, lsum, lane, qt, true);
        } else {
            attn_step<1, 1>(kb, vb, qt, q, o, m, lsum, lane, qt, false);
            attn_step<2, 0>(kb, vb, qt + 1, q, o, m, lsum, lane, qt, false);
            attn_step<1, 0>(kb, vb, qt + 3, q, o, m, lsum, lane, qt, false);
            attn_step<1, 1>(kb, vb, qt + 4, q, o, m, lsum, lane, qt, false);
        }
        lsum += __shfl_xor(lsum, 32);
        const float inv = (float)(1 << F8_MSH) / lsum;
        unsigned char* op = YB + tq * 2048 + 64 * head + 4 * hi;
#pragma unroll
        for (int d0 = 0; d0 < 2; ++d0)
#pragma unroll
            for (int g4 = 0; g4 < 4; ++g4) *(unsigned*)(op + 32 * d0 + 8 * g4) = pk4_fp8(o[d0][4 * g4] * inv, o[d0][4 * g4 + 1] * inv, o[d0][4 * g4 + 2] * inv, o[d0][4 * g4 + 3] * inv);
    }
}
__device__ __forceinline__ void gate_swa_phase(const Frame& F, int l) {
    for (int u = F.bid; u < 1024; u += F.G) {
        if (u < 512) { const int idx = u >> 2, hp = u & 3, b = idx >> 6, jj = idx & 63, j = b == 0 ? jj : 63 - jj; gate_unit(F, b, j, hp); }
        else { const int v = u - 512, b = v >> 8, g = (v >> 7) & 1, blk = v & 127; swa_unit(F, l, b, g, blk); }
    }
    __syncthreads();
}

__device__ __forceinline__ void moba_sel_phase(const Frame& F, int l, int rep) {
    const bf16_t* PROJ = (const bf16_t*)(F.ws + WS_PROJ);
    const unsigned* SEL = (const unsigned*)(F.ws + WS_SEL);
    float* ML = (float*)(F.ws + WS_ML); bf16_t* OPART = (bf16_t*)(F.ws + WS_OPART);
    LAS unsigned char* kb = F.lds; LAS unsigned char* vb = F.lds + 32768;
    LAS unsigned* list = (LAS unsigned*)(F.lds + 65536);
    volatile LAS unsigned* misc = (volatile LAS unsigned*)(F.lds + MISC_OFF);
    const int lane = F.lane, r32 = lane & 31, hi = lane >> 5;
    const float sbound = score_bound(F.ap->in[I_MOBA_QN] + (size_t)l * 64, F.ap->in[I_MOBA_KN] + (size_t)l * 64, lane);
    for (;;) {
        __syncthreads();
        if (F.tid == 0) misc[16] = __hip_atomic_fetch_add(F.ctl + CW_Q + 64 * l + 32 * rep, 1u, RLX_AGENT);
        __syncthreads();
        const int u = (int)misc[16];
        if (u >= 63 * 16) break;
        const int bh = u & 15, n = u >> 4, b = bh >> 3, h = bh & 7;
        const size_t tbat = (size_t)b * SEQ;
        load_kv256(kb, vb, PROJ + (tbat + 256 * n) * PW + KM_OFF + 64 * h, PROJ + (tbat + 256 * n) * PW + VM_OFF + 64 * h, F.tid, 0);
        const int s_first = 256 * (n + 1);
        for (int c = s_first >> 12; c < 4; ++c) {
            __syncthreads();
            if (F.tid == 0) misc[17] = 0u;
            __syncthreads();
#pragma unroll
            for (int k = 0; k < 8; ++k) { const int sl = F.tid + NTHR * k, s = 4096 * c + sl;
                if (s >= s_first) { const unsigned w = SEL[SELIDX(tbat + s, h)];
#pragma unroll
                    for (int slot = 0; slot < 3; ++slot) if (((w >> (8 * slot)) & 255u) == (unsigned)n) { const unsigned idx = atomicAdd((unsigned*)&misc[17], 1u); list[idx] = (unsigned)sl | ((unsigned)slot << 16); } } }
            __syncthreads();
            const int count = (int)misc[17];
            const int ntile = (count + 31) >> 5;
            for (int tile = F.wave; tile < ntile; tile += NWAVES) {
                const int idx = tile * 32 + r32; const bool valid = idx < count;
                const unsigned ent = list[valid ? idx : 0];
                const int s = 4096 * c + (int)(ent & 0xffffu), slot = (int)(ent >> 16);
                const size_t tq = tbat + s;
                bf16x8 q[4];
#pragma unroll
                for (int st = 0; st < 4; ++st) q[st] = *(const bf16x8*)(PROJ + tq * PW + QM_OFF + 64 * h + 16 * st + 8 * hi);
                f32x16 o[2];
#pragma unroll
                for (int r = 0; r < 16; ++r) { o[0][r] = 0.f; o[1][r] = 0.f; }
                float m = sbound, lsum = 0.f;
#pragma unroll 1
                for (int kt = 0; kt < 8; kt += 2) attn_step<2, 0>(kb, vb, kt, q, o, m, lsum, lane, 0, false);
                lsum += __shfl_xor(lsum, 32);
                if (valid) {
                    const size_t p = (tq * 8 + h) * 3 + slot;
                    if (hi == 0) { ML[p * 2] = m; ML[p * 2 + 1] = lsum; }
                    bf16_t* op = OPART + p * 64 + 4 * hi;
#pragma unroll
                    for (int d0 = 0; d0 < 2; ++d0)
#pragma unroll
                        for (int g4 = 0; g4 < 4; ++g4) { u32x2 w; w.x = cvt_pk_bf16(o[d0][4 * g4], o[d0][4 * g4 + 1]); w.y = cvt_pk_bf16(o[d0][4 * g4 + 2], o[d0][4 * g4 + 3]); *(u32x2*)(op + 32 * d0 + 8 * g4) = w; }
                }
            }
        }
    }
}
__device__ __forceinline__ void moba_own_phase(const Frame& F, int l) {
    const bf16_t* PROJ = (const bf16_t*)(F.ws + WS_PROJ);
    const unsigned* SEL = (const unsigned*)(F.ws + WS_SEL);
    const float* ML = (const float*)(F.ws + WS_ML); const bf16_t* OPART = (const bf16_t*)(F.ws + WS_OPART);
    unsigned char* YC = F.ws + WS_YA + 1536;
    const int lane = F.lane, r32 = lane & 31, hi = lane >> 5;
    const float sbound = score_bound(F.ap->in[I_MOBA_QN] + (size_t)l * 64, F.ap->in[I_MOBA_KN] + (size_t)l * 64, lane);
    for (int su = F.bid; su < 512; su += F.G) {
        __syncthreads();
#pragma unroll 1
        for (int which = 0; which < 2; ++which) { const int uu = su * 2 + which, bh = uu >> 6, j = uu & 63, b = bh >> 3, h = bh & 7; const size_t t0 = (size_t)b * SEQ + 256 * j;
            load_kv256(F.lds + which * 65536, F.lds + which * 65536 + 32768, PROJ + t0 * PW + KM_OFF + 64 * h, PROJ + t0 * PW + VM_OFF + 64 * h, F.tid, 0); }
        __syncthreads();
#pragma unroll 1
        for (int which = 0; which < 2; ++which) {
            const int uu = su * 2 + which, bh = uu >> 6, j = uu & 63, b = bh >> 3, h = bh & 7; const size_t t0 = (size_t)b * SEQ + 256 * j;
            const LAS unsigned char* kb = F.lds + which * 65536; const LAS unsigned char* vb = kb + 32768;
            const int qt = which == 0 ? F.wave : 7 - F.wave;
            const size_t tq = t0 + 32 * qt + r32;
            bf16x8 q[4];
#pragma unroll
            for (int st = 0; st < 4; ++st) q[st] = *(const bf16x8*)(PROJ + tq * PW + QM_OFF + 64 * h + 16 * st + 8 * hi);
            f32x16 o[2];
#pragma unroll
            for (int r = 0; r < 16; ++r) { o[0][r] = 0.f; o[1][r] = 0.f; }
            float m = sbound, lsum = 0.f;
            int kt = 0;
#pragma unroll 1
            for (; kt + 2 <= qt; kt += 2) attn_step<2, 0>(kb, vb, kt, q, o, m, lsum, lane, qt, false);
            if (kt < qt) attn_step<2, 2>(kb, vb, kt, q, o, m, lsum, lane, qt, false);
            else attn_step<1, 2>(kb, vb, qt, q, o, m, lsum, lane, qt, false);
            lsum += __shfl_xor(lsum, 32);
            const unsigned sw = SEL[SELIDX(tq, h)];
            float ms[3], ls[3]; float M = m;
#pragma unroll
            for (int slot = 0; slot < 3; ++slot) { const bool ok = ((sw >> (8 * slot)) & 255u) != 255u; const size_t p = (tq * 8 + h) * 3 + slot;
                ms[slot] = ok ? ML[p * 2] : -INFINITY; ls[slot] = ok ? ML[p * 2 + 1] : 0.f; M = fmaxf(M, ms[slot]); }
            const float w_own = __builtin_amdgcn_exp2f(m - M);
            float L = lsum * w_own;
#pragma unroll
            for (int r = 0; r < 16; ++r) { o[0][r] *= w_own; o[1][r] *= w_own; }
#pragma unroll
            for (int slot = 0; slot < 3; ++slot) {
                const float ws = __builtin_amdgcn_exp2f(ms[slot] - M);
                L += ls[slot] * ws;
                if (ms[slot] != -INFINITY) { const bf16_t* op = OPART + ((tq * 8 + h) * 3 + slot) * 64 + 4 * hi;
#pragma unroll
                    for (int d0 = 0; d0 < 2; ++d0)
#pragma unroll
                        for (int g4 = 0; g4 < 4; ++g4) { const u32x2 pv = *(const u32x2*)(op + 32 * d0 + 8 * g4);
                            o[d0][4 * g4] += ws * bflo(pv.x); o[d0][4 * g4 + 1] += ws * bfhi(pv.x); o[d0][4 * g4 + 2] += ws * bflo(pv.y); o[d0][4 * g4 + 3] += ws * bfhi(pv.y); } }
            }
            const float inv = (float)(1 << F8_MSH) / L;
            unsigned char* yp = YC + tq * 2048 + 64 * h + 4 * hi;
#pragma unroll
            for (int d0 = 0; d0 < 2; ++d0)
#pragma unroll
                for (int g4 = 0; g4 < 4; ++g4) *(unsigned*)(yp + 32 * d0 + 8 * g4) = pk4_fp8(o[d0][4 * g4] * inv, o[d0][4 * g4 + 1] * inv, o[d0][4 * g4 + 2] * inv, o[d0][4 * g4 + 3] * inv);
        }
    }
    __syncthreads();
}

__device__ __forceinline__ void route_phase(const Frame& F, int l) {
    const float* LOG = (const float*)(F.ws + WS_LOGITS);
    int* slot_tok = (int*)(F.ws + WS_SLOT_TOK); float* slot_w = (float*)(F.ws + WS_SLOT_W);
    int* tokr = (int*)(F.ws + WS_TOKR);
    LAS int* hist = (LAS int*)F.lds; LAS int* base = hist + 32;
    gu32* cnt = F.ctl + CW_CNT + 64 * l;
    for (int chunk = F.bid; chunk < T / 128; chunk += F.G) {
        __syncthreads();
        if (F.tid < 32) hist[F.tid] = 0;
        __syncthreads();
        int e0 = 0, e1 = 0, r0 = 0, r1 = 0; float w0 = 0.f, w1 = 0.f; const int t = chunk * 128 + F.tid;
        if (F.tid < 128) {
            const float* lg = LOG + (size_t)t * 64; const float* lg2 = lg + (size_t)T * 64;
            float gl[4]; const f32x4 g4 = *(const f32x4*)lg + *(const f32x4*)lg2; gl[0] = g4[0]; gl[1] = g4[1]; gl[2] = g4[2]; gl[3] = g4[3];
            int gs = 0; float gm = gl[0];
#pragma unroll
            for (int i = 1; i < 4; ++i) if (gl[i] > gm) { gm = gl[i]; gs = i; }
            float den = 0.f;
#pragma unroll
            for (int i = 0; i < 4; ++i) den += __expf(gl[i] - gm);
            const float pg = 1.0f / den;
            float el[8]; const f32x4 ea = *(const f32x4*)(lg + 4 + 8 * gs) + *(const f32x4*)(lg2 + 4 + 8 * gs), eb = *(const f32x4*)(lg + 8 + 8 * gs) + *(const f32x4*)(lg2 + 8 + 8 * gs);
            el[0] = ea[0]; el[1] = ea[1]; el[2] = ea[2]; el[3] = ea[3]; el[4] = eb[0]; el[5] = eb[1]; el[6] = eb[2]; el[7] = eb[3];
            int a0 = 0; float m0 = el[0];
#pragma unroll
            for (int i = 1; i < 8; ++i) if (el[i] > m0) { m0 = el[i]; a0 = i; }
            int a1 = -1; float m1 = -INFINITY;
#pragma unroll
            for (int i = 0; i < 8; ++i) if (i != a0 && el[i] > m1) { m1 = el[i]; a1 = i; }
            const float x1 = __expf(m1 - m0); const float inv = 1.0f / (1.0f + x1);
            w0 = pg * inv; w1 = pg * x1 * inv; e0 = gs * 8 + a0; e1 = gs * 8 + a1;
            r0 = atomicAdd((int*)&hist[e0], 1); r1 = atomicAdd((int*)&hist[e1], 1);
        }
        __syncthreads();
        if (F.tid < 32) { const int hc = hist[F.tid]; base[F.tid] = hc ? (int)__hip_atomic_fetch_add(cnt + F.tid, (unsigned)hc, RLX_AGENT) : 0; }
        __syncthreads();
        if (F.tid < 128) {
            r0 += base[e0]; r1 += base[e1];
            slot_tok[(size_t)e0 * CAP + r0] = t; slot_w[(size_t)e0 * CAP + r0] = w0;
            slot_tok[(size_t)e1 * CAP + r1] = t; slot_w[(size_t)e1 * CAP + r1] = w1;
            tokr[t * 4 + 0] = e0; tokr[t * 4 + 1] = r0; tokr[t * 4 + 2] = e1; tokr[t * 4 + 3] = r1;
        }
    }
    __syncthreads();
}

template <bool G1>
struct MoeSched {
    static constexpr bool GATHER = G1;
    const char* A; const char* B; const gu32* cnt; const LAS int* bb; const int* slot_tok; int Kb, G, c, nunits;
    __device__ __forceinline__ bool next(int i, pg8::Unit& u) const {
        const int L = i * G + c; if (L >= nunits) return false;
        int f = L; { const int q = nunits / 8, r = nunits % 8, xcd = f % 8, off = f / 8; f = (xcd < r ? xcd * (q + 1) : r * (q + 1) + (xcd - r) * q) + off; }
        const int cb = f >> 3; u.pn = f & 7; u.pm = cb;
        int e = 0;
#pragma unroll
        for (int st = 16; st >= 1; st >>= 1) { const int t2 = __builtin_amdgcn_readfirstlane(bb[e + st]); if (t2 <= cb) e += st; }
        const int b0 = __builtin_amdgcn_readfirstlane(bb[e]);
        const int ce = (int)__builtin_amdgcn_readfirstlane(__hip_atomic_load(cnt + e, RLX_AGENT));
        u.e = e; u.rank0 = (cb - b0) * 256; const int rem = ce - u.rank0; u.nrow = rem < 256 ? rem : 256;
        return true;
    }
    __device__ __forceinline__ const char* a_base(const pg8::Unit& u) const { return G1 ? A : A + (size_t)u.pm * 256 * Kb; }
    __device__ __forceinline__ const char* b_base(const pg8::Unit& u) const { return B + ((size_t)u.e * 2048 + (size_t)u.pn * 256) * Kb; }
    __device__ __forceinline__ unsigned gather(const pg8::Unit& u, int R) const { const int tok = (R < u.nrow) ? slot_tok[(size_t)u.e * CAP + u.rank0 + R] : 0; return (unsigned)tok * (unsigned)Kb; }
};

constexpr int PH_PER_LAYER = 13, N_PHASES = 2 * PH_PER_LAYER + 1;
#ifndef PHMASK
#define PHMASK 0xFFFFFFFFu
#endif
#define IN(k) (((PHMASK >> ((k) % PH_PER_LAYER)) & 1u) && lo <= (k) && (k) < hi)
#define SEAM(k) do { if (IN(k) && IN((k) + 1)) xcd_barrier(bar); } while (0)
#define PH_BEGIN() do { int t_ = threadIdx.x; asm volatile("" : "+v"(t_)); F.tid = t_; F.lane = t_ & 63; F.wave = __builtin_amdgcn_readfirstlane(t_ >> 6); \
        ArgsP ap_ = (ArgsP)__builtin_amdgcn_kernarg_segment_ptr(); asm volatile("" : "+s"(ap_)); F.ap = ap_; F.ws = ap_->ws; F.ctl = (gu32*)(ap_->ws + WS_CTL); } while (0)
#define REP(k) for (int rep_ = 0; rep_ < ((l == 0 && PROBE_DUP == (k)) ? 2 : 1); ++rep_)
#define AIN(i) (F.ap->in[i])
#define AOUT (F.ap->out)
#define WSB(off) (F.ws + (off))


template <int l>
__device__ __forceinline__ void layer_phases(Frame& F, const int lo, const int hi, const XcdBarrier& bar) {
        constexpr int pb = l * PH_PER_LAYER;
        if (IN(pb + 0)) REP(0) { PH_BEGIN(); if (rep_) xcd_barrier(bar);
            conv_phase(F, l);
            if (l == 0) norm_phase<0>(F, AIN(I_X), AOUT, AIN(I_NORM_MIX), nullptr);
            else norm_phase<2>(F, nullptr, AOUT, AIN(I_NORM_MIX) + (size_t)l * D, F.ctl + CW_CNT + 64 * (l - 1));
        }
        SEAM(pb + 0);
        if (IN(pb + 1)) REP(1) { PH_BEGIN(); if (rep_) xcd_barrier(bar);
            if (FP8_IN) { pg8::UnevenSched S{WSB(WS_H8), WSB(WS_WIN8), T / 256, 24, D, F.G, F.bid};
              pg8::EpiGate8 E{WSB(WS_G8A)};
              pg8::gemm_phase<pg8::EpiGate8, pg8::UnevenSched, true, true, true, 127 - F8_WSH, 127 - F8_HSH>(F.lds, D, S, E); }
            else { pg8::DenseSched S{WSB(WS_H), (const bf16_t*)WSB(WS_WIN) + (size_t)3328 * D, T / 256, 24, 2 * D, F.G, F.bid};
              pg8::EpiProj<true> E{(bf16_t*)WSB(WS_PROJ), 13};
              pg8::gemm_phase<pg8::EpiProj<true>, pg8::DenseSched, true, true>(F.lds, 2 * D, S, E); }
            PH_BEGIN();
            { pg8::DenseSched S{WSB(WS_X), WSB(WS_WIN), T / 256, 13, 2 * D, F.G, F.bid};
              pg8::EpiProj<false> E{(bf16_t*)WSB(WS_PROJ), 0, (const float*)WSB(WS_RS1)};
              pg8::gemm_phase<pg8::EpiProj<false>, pg8::DenseSched, true, true>(F.lds, 2 * D, S, E); }
        }
        SEAM(pb + 1);
        if (IN(pb + 2)) REP(2) { PH_BEGIN(); if (rep_) xcd_barrier(bar); prep_phase(F, l); }
        SEAM(pb + 2);
        if (IN(pb + 3)) REP(3) { PH_BEGIN(); if (rep_) xcd_barrier(bar); gate_swa_phase(F, l); }
        SEAM(pb + 3);
        if (IN(pb + 4)) REP(4) { PH_BEGIN(); if (rep_) xcd_barrier(bar); moba_sel_phase(F, l, rep_); }
        SEAM(pb + 4);
        if (IN(pb + 5)) REP(5) { PH_BEGIN(); if (rep_) xcd_barrier(bar); moba_own_phase(F, l); }
        SEAM(pb + 5);
        if (IN(pb + 6)) REP(6) { PH_BEGIN(); if (rep_) xcd_barrier(bar);
            static_assert(FP8_O == 1, "the fused up-projection writes the fp8 operand of the output projection");
            pg8::DenseSched S{WSB(WS_YA), WSB(WS_WUPA), T / 256, D / 256, D, F.G, F.bid}; pg8::EpiUpH E{WSB(WS_G8A), WSB(WS_H8)};
            pg8::gemm_phase<pg8::EpiUpH, pg8::DenseSched, true, true, true, 127 - F8_WSH, 127 - F8_MSH>(F.lds, D, S, E);
        }
        SEAM(pb + 6);
        if (IN(pb + 7)) REP(7) { PH_BEGIN(); if (rep_) xcd_barrier(bar);
            constexpr int EB = FP8_O ? 1 : 2; constexpr bool F8 = FP8_O != 0;
            pg8::DenseSched S{WSB(FP8_O ? WS_H8 : WS_MERGED), WSB(WS_WO), T / 256, D / 256, EB * D, F.G, F.bid};
            { pg8::EpiResid<false> E{nullptr, (bf16_t*)WSB(WS_X)}; pg8::gemm_phase<pg8::EpiResid<false>, pg8::DenseSched, true, true, F8, 127 - F8_WSH, 127 - F8_HSH>(F.lds, EB * D, S, E); }
        }
        SEAM(pb + 7);
        if (IN(pb + 8)) REP(8) { PH_BEGIN(); if (rep_) xcd_barrier(bar); norm_phase<1>(F, nullptr, AOUT, AIN(I_NORM_FFN) + (size_t)l * D, nullptr); }
        SEAM(pb + 8);
        if (IN(pb + 9)) REP(9) { PH_BEGIN(); if (rep_) xcd_barrier(bar);
            pg8::SplitKSched S{WSB(WS_X), WSB(WS_WR), T / 256, 2 * D, F.G, F.bid};
            pg8::EpiLogits E{(float*)WSB(WS_LOGITS), (const float*)WSB(WS_RS2), 1.0f};
            pg8::gemm_phase<pg8::EpiLogits, pg8::SplitKSched, false, true>(F.lds, 2 * D, S, E, 16);
        }
        SEAM(pb + 9);
        if (IN(pb + 10)) REP(10) { PH_BEGIN(); if (rep_) xcd_barrier(bar); route_phase(F, l); }
        SEAM(pb + 10);
        if (IN(pb + 11)) REP(11) { PH_BEGIN(); if (rep_) xcd_barrier(bar);
            build_blkbase(F, F.ctl + CW_CNT + 64 * l);
            const LAS int* bb = (const LAS int*)(F.lds + MISC_OFF + 256);
            constexpr int EB = FP8_MOE ? 1 : 2;
            MoeSched<true> S{(const char*)WSB(FP8_MOE ? WS_H8 : WS_H), (const char*)WSB(WS_W13), F.ctl + CW_CNT + 64 * l, bb, (const int*)WSB(WS_SLOT_TOK), D * EB, F.G, F.bid, __builtin_amdgcn_readfirstlane(bb[32]) * 8};
            pg8::EpiAct<FP8_MOE != 0> E{WSB(WS_ACT)};
            pg8::gemm_phase<pg8::EpiAct<FP8_MOE != 0>, MoeSched<true>, true, true, FP8_MOE != 0, 127 - F8_WSH, 127 - F8_HSH>(F.lds, D * EB, S, E);
        }
        SEAM(pb + 11);
        if (IN(pb + 12)) REP(12) { PH_BEGIN(); if (rep_) xcd_barrier(bar);
            build_blkbase(F, F.ctl + CW_CNT + 64 * l);
            const LAS int* bb = (const LAS int*)(F.lds + MISC_OFF + 256);
            constexpr int EB = FP8_MOE ? 1 : 2;
            MoeSched<false> S{(const char*)WSB(WS_ACT), (const char*)WSB(WS_WD), F.ctl + CW_CNT + 64 * l, bb, (const int*)WSB(WS_SLOT_TOK), FF * EB, F.G, F.bid, __builtin_amdgcn_readfirstlane(bb[32]) * 8};
            pg8::EpiDown E{WSB(WS_Y), (const float*)WSB(WS_SLOT_W)};
            pg8::gemm_phase<pg8::EpiDown, MoeSched<false>, true, true, FP8_MOE != 0, 127 - F8_WSH, 127 - F8_ASH>(F.lds, FF * EB, S, E);
        }
        SEAM(pb + 12);
}

__global__ void __launch_bounds__(NTHR, 2) fwd(Args kargs) {
    extern __shared__ __attribute__((aligned(16))) unsigned char lds_raw[];
    Frame F;
    F.lds = (LAS unsigned char*)lds_raw; F.ap = (ArgsP)__builtin_amdgcn_kernarg_segment_ptr(); F.ws = F.ap->ws; F.ctl = (gu32*)(F.ws + WS_CTL);
    F.tid = threadIdx.x; F.lane = F.tid & 63; F.wave = __builtin_amdgcn_readfirstlane(F.tid >> 6); F.G = gridDim.x; F.bid = blockIdx.x;
    for (int u = F.tid; u < (LDS_BYTES - MISC_OFF) / 4; u += NTHR) ((LAS unsigned*)(F.lds + MISC_OFF))[u] = 0u;
    __syncthreads();
    const int lo = kargs.ph_lo, hi = kargs.ph_hi;
    const bool fused = (hi - lo) > 1;
    XcdBarrier bar; bar.bar = (unsigned*)(F.ctl + CW_BAR); bar.x = 0; bar.st = nullptr;
    if (fused) bar = xcd_barrier_post((unsigned*)(F.ctl + CW_BAR), (volatile LAS unsigned*)(F.lds + MISC_OFF) + 8);
    layer_phases<0>(F, lo, hi, bar);
    layer_phases<1>(F, lo, hi, bar);
    if (IN(2 * PH_PER_LAYER)) { PH_BEGIN(); norm_phase<3>(F, nullptr, AOUT, nullptr, F.ctl + CW_CNT + 64 * (DEPTH - 1)); }
#undef IN
#undef SEAM
#undef PH_BEGIN
#undef AIN
#undef REP
#undef AOUT
#undef WSB
}

extern "C" void kernel_launch(void* const* d_in, const int* in_sizes, int n_in, void* d_out, int out_size, void* d_ws, size_t ws_size, hipStream_t stream) {
    static int grid = 0;
    if (grid == 0) {
        if (n_in != 20 || in_sizes[0] != T * D || out_size != T * D || ws_size < WS_END) { fprintf(stderr, "kernel_launch: unexpected shapes (n_in %d, in0 %d, out %d, ws %zu < %zu)\n", n_in, n_in > 0 ? in_sizes[0] : -1, out_size, ws_size, (size_t)WS_END); grid = -1; return; }
        int dev = 0, cus = 0, per_cu = 0;
        if (hipGetDevice(&dev) != hipSuccess || hipDeviceGetAttribute(&cus, hipDeviceAttributeMultiprocessorCount, dev) != hipSuccess) { grid = -1; return; }
        if (hipFuncSetAttribute((const void*)fwd, hipFuncAttributeMaxDynamicSharedMemorySize, LDS_BYTES) != hipSuccess) { fprintf(stderr, "kernel_launch: hipFuncSetAttribute failed\n"); grid = -1; return; }
        if (hipOccupancyMaxActiveBlocksPerMultiprocessor(&per_cu, (const void*)fwd, NTHR, LDS_BYTES) != hipSuccess || per_cu < 1) fprintf(stderr, "kernel_launch: occupancy query says %d\n", per_cu);
        (void)hipGetLastError();
        grid = cus;
    }
    if (grid < 0) return;
    (void)hipMemsetAsync((char*)d_ws + WS_CTL, 0, CTL_ZERO_BYTES, stream);
    Args a{};
    for (int i = 0; i < 20; ++i) a.in[i] = (const float*)d_in[i];
    a.out = (float*)d_out; a.ws = (unsigned char*)d_ws;
    for (int i = 0; i < 32; ++i) a.inv_freq[i] = 1.0f / powf(10000.0f, (float)(2 * i) / 64.0f);
#if MK_N_LAUNCHES == 1
    a.ph_lo = 0; a.ph_hi = N_PHASES;
    hipLaunchKernelGGL(fwd, dim3(grid), dim3(NTHR), LDS_BYTES, stream, a);
#else
    for (int p = 0; p < N_PHASES; ++p) { a.ph_lo = p; a.ph_hi = p + 1; hipLaunchKernelGGL(fwd, dim3(grid), dim3(NTHR), LDS_BYTES, stream, a); }
#endif
}
```
